# Optimizing an MI355X kernel written in HIP

```python
import math
import jax, jax.numpy as jnp
from jax import lax
import numpy as np

D_MODEL = 1024
BATCH = 8
SEQ = 4096
DEPTH = 1

CONV_DIM = D_MODEL
CONV_WIDTH = 31
GMLP_DIM = D_MODEL
GMLP_HEADS = 8
GMLP_HEAD_DIM = GMLP_DIM // GMLP_HEADS
CHUNK = 128
N_EXPERTS = 32
TOP_K = 4
D_EXPERT = D_MODEL
SWIGLU_ALPHA = 1.702
SWIGLU_LIMIT = 7.0
MOE_BLOCK = 256
LN_EPS = 1e-5
DEEPNORM_ALPHA = (2.0 * DEPTH) ** 0.25
DEEPNORM_BETA = (8.0 * DEPTH) ** -0.25
N_MOD = 6
IN_WIDTHS = (CONV_DIM, CONV_DIM, GMLP_DIM, GMLP_DIM, D_MODEL, D_MODEL)
IN_DIM = sum(IN_WIDTHS)
IN_SPLITS = tuple(int(s) for s in np.cumsum(IN_WIDTHS)[:-1])

kernel_name = "conformer_gmlp_moe_deepnorm_block"


def _layer_norm(x):
    xf = x.astype(jnp.float32)
    mu = jnp.mean(xf, axis=-1, keepdims=True)
    var = jnp.mean(jnp.square(xf - mu), axis=-1, keepdims=True)
    return ((xf - mu) * lax.rsqrt(var + LN_EPS)).astype(x.dtype)


def _ln_affine(x, g, b):
    return _layer_norm(x) * g + b


def _conformer_conv(a_val, a_gate, conv_w, conv_b, ln_g, ln_b, w_pa, b_pa):
    z = a_val * jax.nn.sigmoid(a_gate)
    z = jnp.pad(z, ((0, 0), (CONV_WIDTH - 1, 0), (0, 0)))
    z = lax.conv_general_dilated(
        z, conv_w[:, None, :], window_strides=(1,), padding="VALID",
        dimension_numbers=("NWC", "WIO", "NWC"),
        feature_group_count=CONV_DIM) + conv_b
    z = jax.nn.silu(_ln_affine(z, ln_g, ln_b))
    return z @ w_pa + b_pa


def _chunked_spatial_gating(u, v, ln_g, ln_b, w_s, b_s, w_pb, b_pb):
    bsz, seq, _ = u.shape
    n_chunks = seq // CHUNK
    u = jax.nn.gelu(u, approximate=False)
    v = _ln_affine(jax.nn.gelu(v, approximate=False), ln_g, ln_b)
    v = v.reshape(bsz, n_chunks, CHUNK, GMLP_HEADS, GMLP_HEAD_DIM)
    causal = jnp.tril(jnp.ones((CHUNK, CHUNK), dtype=bool))
    w_causal = jnp.where(causal[None], w_s, 0.0)
    mixed = jnp.einsum("hts,bnshd->bnthd", w_causal, v) + b_s.T[:, :, None]
    gated = u * mixed.reshape(bsz, seq, GMLP_DIM)
    return gated @ w_pb + b_pb


def _mixer(h, w_in, b_in, conv_w, conv_b, ln_a_g, ln_a_b, w_pa, b_pa,
           ln_v_g, ln_v_b, w_s, b_s, w_pb, b_pb, w_out, b_out):
    proj = h @ w_in + b_in
    a_val, a_gate, u, v, g_a, g_b = jnp.split(proj, IN_SPLITS, axis=-1)
    y_a = _conformer_conv(a_val, a_gate, conv_w, conv_b, ln_a_g, ln_a_b, w_pa, b_pa)
    y_b = _chunked_spatial_gating(u, v, ln_v_g, ln_v_b, w_s, b_s, w_pb, b_pb)
    merged = jax.nn.sigmoid(g_a) * y_a + jax.nn.sigmoid(g_b) * y_b
    return merged @ w_out + b_out


def _moe(h, w_router, b_router, w_up, b_up, w_down, b_down):
    bsz, seq, dm = h.shape
    n_tok = bsz * seq
    hf = h.reshape(n_tok, dm)
    logits = (hf @ w_router + b_router).astype(jnp.float32)
    top_logit, top_idx = lax.top_k(logits, TOP_K)
    top_w = jax.nn.softmax(top_logit, axis=-1).astype(h.dtype)
    n_assign = n_tok * TOP_K
    flat_e = top_idx.reshape(n_assign)
    flat_tok = jnp.repeat(jnp.arange(n_tok, dtype=jnp.int32), TOP_K)
    flat_w = top_w.reshape(n_assign)
    order = jnp.argsort(flat_e)
    sorted_e = flat_e[order]
    counts = jnp.bincount(flat_e, length=N_EXPERTS)
    padded = (counts + MOE_BLOCK - 1) // MOE_BLOCK * MOE_BLOCK
    start = jnp.cumsum(counts) - counts
    padded_end = jnp.cumsum(padded)
    padded_start = padded_end - padded
    dest = padded_start[sorted_e] + jnp.arange(n_assign, dtype=jnp.int32) - start[sorted_e]
    n_blocks = -(-n_assign // MOE_BLOCK) + N_EXPERTS
    n_rows = n_blocks * MOE_BLOCK
    row_tok = jnp.zeros((n_rows,), jnp.int32).at[dest].set(flat_tok[order])
    row_w = jnp.zeros((n_rows,), h.dtype).at[dest].set(flat_w[order])
    block_expert = jnp.minimum(
        jnp.searchsorted(padded_end, jnp.arange(n_blocks) * MOE_BLOCK, side="right"),
        N_EXPERTS - 1)
    xg = hf[row_tok].reshape(n_blocks, MOE_BLOCK, dm)

    def expert_block(args):
        xb, e = args
        z = xb @ w_up[e] + b_up[e]
        glu, lin = jnp.split(z, 2, axis=-1)
        glu = jnp.minimum(glu, SWIGLU_LIMIT)
        lin = jnp.clip(lin, -SWIGLU_LIMIT, SWIGLU_LIMIT)
        act = glu * jax.nn.sigmoid(SWIGLU_ALPHA * glu) * (lin + 1.0)
        return act @ w_down[e] + b_down[e]

    yg = lax.map(expert_block, (xg, block_expert)).reshape(n_rows, dm)
    out = jnp.zeros_like(hf).at[row_tok].add(yg * row_w[:, None])
    return out.reshape(bsz, seq, dm)


def setup_inputs(seed: int = 0) -> dict:
    key = jax.random.key(seed)
    ks = jax.random.split(key, 32)
    L = DEPTH

    def nrm(k, shape, scale):
        return jax.random.normal(k, shape, jnp.float32) * scale

    def gain(k, shape):
        return 1.0 + nrm(k, shape, 0.02)

    return {
        "x": nrm(ks[0], (BATCH, SEQ, D_MODEL), 1.0),
        "c": nrm(ks[1], (BATCH, D_MODEL), 1.0),
        "w_ada": nrm(ks[2], (L, D_MODEL, N_MOD * D_MODEL), 0.5 * D_MODEL ** -0.5),
        "b_ada": nrm(ks[3], (L, N_MOD * D_MODEL), 0.02),
        "w_in": nrm(ks[4], (L, D_MODEL, IN_DIM), D_MODEL ** -0.5),
        "b_in": nrm(ks[5], (L, IN_DIM), 0.02),
        "conv_w": nrm(ks[6], (L, CONV_WIDTH, CONV_DIM), CONV_WIDTH ** -0.5),
        "conv_b": nrm(ks[7], (L, CONV_DIM), 0.02),
        "ln_a_g": gain(ks[8], (L, CONV_DIM)),
        "ln_a_b": nrm(ks[9], (L, CONV_DIM), 0.02),
        "w_pa": nrm(ks[10], (L, CONV_DIM, D_MODEL), DEEPNORM_BETA * CONV_DIM ** -0.5),
        "b_pa": nrm(ks[11], (L, D_MODEL), 0.02),
        "ln_v_g": gain(ks[12], (L, GMLP_DIM)),
        "ln_v_b": nrm(ks[13], (L, GMLP_DIM), 0.02),
        "w_s": nrm(ks[14], (L, GMLP_HEADS, CHUNK, CHUNK), CHUNK ** -0.5),
        "b_s": gain(ks[15], (L, GMLP_HEADS, CHUNK)),
        "w_pb": nrm(ks[16], (L, GMLP_DIM, D_MODEL), DEEPNORM_BETA * GMLP_DIM ** -0.5),
        "b_pb": nrm(ks[17], (L, D_MODEL), 0.02),
        "w_out": nrm(ks[18], (L, D_MODEL, D_MODEL), DEEPNORM_BETA * D_MODEL ** -0.5),
        "b_out": nrm(ks[19], (L, D_MODEL), 0.02),
        "post1_g": gain(ks[20], (L, D_MODEL)),
        "post1_b": nrm(ks[21], (L, D_MODEL), 0.02),
        "w_router": nrm(ks[22], (L, D_MODEL, N_EXPERTS), D_MODEL ** -0.5),
        "b_router": nrm(ks[23], (L, N_EXPERTS), 0.01),
        "w_up": nrm(ks[24], (L, N_EXPERTS, D_MODEL, 2 * D_EXPERT), D_MODEL ** -0.5),
        "b_up": nrm(ks[25], (L, N_EXPERTS, 2 * D_EXPERT), 0.02),
        "w_down": nrm(ks[26], (L, N_EXPERTS, D_EXPERT, D_MODEL), DEEPNORM_BETA * D_EXPERT ** -0.5),
        "b_down": nrm(ks[27], (L, N_EXPERTS, D_MODEL), 0.02),
        "post2_g": gain(ks[28], (L, D_MODEL)),
        "post2_b": nrm(ks[29], (L, D_MODEL), 0.02),
    }


def reference(x, c, w_ada, b_ada, w_in, b_in, conv_w, conv_b, ln_a_g, ln_a_b, w_pa, b_pa,
              ln_v_g, ln_v_b, w_s, b_s, w_pb, b_pb, w_out, b_out, post1_g, post1_b,
              w_router, b_router, w_up, b_up, w_down, b_down, post2_g, post2_b):
    cond = jax.nn.silu(c)
    for l in range(DEPTH):
        mod = cond @ w_ada[l] + b_ada[l]
        shift1, scale1, gate1, shift2, scale2, gate2 = [
            m[:, None, :] for m in jnp.split(mod, N_MOD, axis=-1)]
        h = _layer_norm(x) * (1.0 + scale1) + shift1
        y = _mixer(h, w_in[l], b_in[l], conv_w[l], conv_b[l], ln_a_g[l], ln_a_b[l],
                   w_pa[l], b_pa[l], ln_v_g[l], ln_v_b[l], w_s[l], b_s[l],
                   w_pb[l], b_pb[l], w_out[l], b_out[l])
        x = _ln_affine(DEEPNORM_ALPHA * x + gate1 * y, post1_g[l], post1_b[l])
        h = _layer_norm(x) * (1.0 + scale2) + shift2
        y = _moe(h, w_router[l], b_router[l], w_up[l], b_up[l], w_down[l], b_down[l])
        x = _ln_affine(DEEPNORM_ALPHA * x + gate2 * y, post2_g[l], post2_b[l])
    return x
```

```cpp
#include <hip/hip_runtime.h>
#include <cstdio>
#include <cstdint>

#ifndef MK_N_LAUNCHES
#define MK_N_LAUNCHES 11
#endif

namespace pg8 {
#define PG8_LAS __attribute__((address_space(3)))
typedef unsigned short bf16_t;
typedef short bf16x8 __attribute__((ext_vector_type(8)));
typedef float f32x4 __attribute__((ext_vector_type(4)));
typedef float f32x2 __attribute__((ext_vector_type(2)));
typedef unsigned u32x4 __attribute__((ext_vector_type(4)));
typedef unsigned u32x2 __attribute__((ext_vector_type(2)));
constexpr int BM = 256, BK = 64, HALF = 128, HTB = HALF * BK * 2  , STAGE_BYTES = 8 * HTB, NXCD = 8, WGM = 8;

__host__ __device__ __forceinline__ int lds_byte(int r, int c) { const int st = (r >> 4) * 2 + (c >> 5), rr = r & 15, cc = c & 31, ob = rr * 64 + cc * 2; return st * 1024 + (ob ^ (((ob >> 9) & 1) << 5)); }
__host__ __device__ __forceinline__ void stage_rc(int b, int& R, int& C) { const int st = b / 1024, sb = b % 1024, swz = sb ^ (((sb >> 9) & 1) << 5); R = (st >> 1) * 16 + swz / 64; C = (st & 1) * 32 + (swz % 64) / 2; }
__host__ __device__ __forceinline__ int perm32(int rho) { const int n = rho >> 4, i = rho & 15; return 8 * (i >> 2) + 4 * n + (i & 3); }

struct Unit { int pn; int row0; int e; int nvalid; };

struct DenseOrder {
    int nM, nN, nwg, G, c; const char* A; const char* Bt; size_t rowbytes, tstep;
    __device__ __forceinline__ void init(const bf16_t* A_, const bf16_t* Bt_, int M, int N, int K, int G_, int c_) { nM = M / BM; nN = N / BM; nwg = nM * nN; G = G_; c = c_; A = (const char*)A_; Bt = (const char*)Bt_; rowbytes = (size_t)K * 2; tstep = (size_t)BM * K * 2; }
    __device__ __forceinline__ bool next(int i, Unit& u) const {
        const long L = (long)i * G + c; if (L >= nwg) return false;
        int wgid = (int)L; { const int q = nwg / NXCD, r = nwg % NXCD, xcd = wgid % NXCD, off = wgid / NXCD; wgid = (xcd < r ? xcd * (q + 1) : r * (q + 1) + (xcd - r) * q) + off; }
        const int nig = WGM * nN, gid = wgid / nig, fm = gid * WGM, gsz = (nM - fm) < WGM ? (nM - fm) : WGM;
        const int pm = fm + ((wgid % nig) % gsz); u.pn = (wgid % nig) / gsz; u.row0 = pm * BM; u.e = 0; u.nvalid = BM; return true;
    }
    __device__ __forceinline__ const char* abase(const Unit& u) const { return A + (size_t)u.row0 * rowbytes; }
    __device__ __forceinline__ const char* bbase(const Unit& u) const { return Bt + (size_t)u.pn * tstep; }
    __device__ __forceinline__ void a_ready(const Unit&) const {}
    __device__ __forceinline__ void done(const Unit&) const {}
};
struct GroupedOrder {
    const PG8_LAS int* tp; const PG8_LAS int* rs; const PG8_LAS int* cnt; int npn, G, c; const char* A; const char* Bt; size_t rowbytes, tstep, estride;
    __device__ __forceinline__ bool next(int i, Unit& u) const {
        const int L = i * G + c; const int tot = __builtin_amdgcn_readfirstlane(tp[32]); if (L >= tot) return false;
        int e = 0;
        for (int j = 1; j < 32; ++j) e += (L >= __builtin_amdgcn_readfirstlane(tp[j])) ? 1 : 0;
        const int local = L - __builtin_amdgcn_readfirstlane(tp[e]); const int mt = local / npn; u.pn = local - mt * npn; u.e = e;
        u.row0 = __builtin_amdgcn_readfirstlane(rs[e]) + BM * mt; const int left = __builtin_amdgcn_readfirstlane(cnt[e]) - BM * mt; u.nvalid = left < BM ? left : BM; return true;
    }
    __device__ __forceinline__ const char* abase(const Unit& u) const { return A + (size_t)u.row0 * rowbytes; }
    __device__ __forceinline__ const char* bbase(const Unit& u) const { return Bt + (size_t)u.e * estride + (size_t)u.pn * tstep; }
    __device__ __forceinline__ void a_ready(const Unit&) const {}
    __device__ __forceinline__ void done(const Unit&) const {}
};

__device__ __forceinline__ unsigned cvt_pk_bf16(float lo, float hi) { unsigned r; asm volatile("v_cvt_pk_bf16_f32 %0, %1, %2" : "=v"(r) : "v"(lo), "v"(hi)); return r; }
__device__ __forceinline__ float bf_lo(unsigned w) { return __uint_as_float(w << 16); }
__device__ __forceinline__ float bf_hi(unsigned w) { return __uint_as_float(w & 0xffff0000u); }
__device__ __forceinline__ f32x2 gelu_pk(f32x2 v) {
    const f32x2 av = __builtin_elementwise_abs(v), d = av * 0.2316418882f + 1.0f;
    f32x2 t; t.x = __builtin_amdgcn_rcpf(d.x); t.y = __builtin_amdgcn_rcpf(d.y);
    f32x2 q = t * 0.5307027145f + (-0.7265760135f); q = q * t + 0.7107068705f; q = q * t + (-0.142248368f); q = q * t + 0.127414796f; q = q * t;
    const f32x2 s = (v * v) * (-0.72134752044f);
    f32x2 e; e.x = __builtin_amdgcn_exp2f(s.x); e.y = __builtin_amdgcn_exp2f(s.y);
    const f32x2 m = v * (q * e), r = v - m;
    f32x2 o; o.x = v.x < 0.f ? m.x : r.x; o.y = v.y < 0.f ? m.y : r.y; return o;
}
__device__ __forceinline__ f32x4 gelu4(f32x4 v) { const f32x2 a = gelu_pk((f32x2){v[0], v[1]}), b = gelu_pk((f32x2){v[2], v[3]}); return (f32x4){a.x, a.y, b.x, b.y}; }
__device__ __forceinline__ float sigm(float x) { return __builtin_amdgcn_rcpf(1.0f + __builtin_amdgcn_exp2f(-1.44269504089f * x)); }
__device__ __forceinline__ f32x4 sigm4(f32x4 v) { return (f32x4){sigm(v[0]), sigm(v[1]), sigm(v[2]), sigm(v[3])}; }
__device__ __forceinline__ u32x4 pack8(f32x4 v0, f32x4 v1) { u32x4 w; w.x = cvt_pk_bf16(v0[0], v0[1]); w.y = cvt_pk_bf16(v0[2], v0[3]); w.z = cvt_pk_bf16(v1[0], v1[1]); w.w = cvt_pk_bf16(v1[2], v1[3]); return w; }
__device__ __forceinline__ void unpack8(u32x4 w, f32x4& v0, f32x4& v1) { v0 = (f32x4){bf_lo(w.x), bf_hi(w.x), bf_lo(w.y), bf_hi(w.y)}; v1 = (f32x4){bf_lo(w.z), bf_hi(w.z), bf_lo(w.w), bf_hi(w.w)}; }

constexpr int LDC = 1024;

struct EpiG1 {
    static constexpr bool PERM = true, AFTER_DRAIN = false;
    bf16_t *Z, *GU; size_t tstride; const float* bias;
    __device__ __forceinline__ void operator()(const f32x4 (&acc)[2][2][4][2], const Unit& u, int wr, int wc, int fr, int fq) const {
        const int row0 = u.row0 + wr * 64 + fr, bcol0 = u.pn * BM + wc * 32 + 8 * fq;
        f32x4 bv[2][2];
#pragma unroll
        for (int bj = 0; bj < 2; ++bj)
#pragma unroll
            for (int n = 0; n < 2; ++n) bv[bj][n] = *(const f32x4*)(bias + bcol0 + bj * HALF + 4 * n);
        if (u.pn < 8) {
            const int col0 = u.pn * HALF + wc * 32 + 8 * fq;
#pragma unroll
            for (int ai = 0; ai < 2; ++ai)
#pragma unroll
                for (int m = 0; m < 4; ++m) { bf16_t* rowp = Z + (size_t)(row0 + ai * HALF + m * 16) * LDC + col0;
                    const f32x4 v0 = acc[ai][0][m][0] + bv[0][0], v1 = acc[ai][0][m][1] + bv[0][1], g0 = acc[ai][1][m][0] + bv[1][0], g1 = acc[ai][1][m][1] + bv[1][1];
                    *(u32x4*)rowp = pack8(v0 * sigm4(g0), v1 * sigm4(g1)); }
        } else {
            const int t = (u.pn - 8) >> 2; bf16_t* base = GU + (size_t)t * tstride;
            const int col0 = ((u.pn - 8) & 3) * BM + wc * 32 + 8 * fq;
#pragma unroll
            for (int ai = 0; ai < 2; ++ai)
#pragma unroll
                for (int m = 0; m < 4; ++m) { bf16_t* rowp = base + (size_t)(row0 + ai * HALF + m * 16) * LDC + col0;
#pragma unroll
                    for (int bj = 0; bj < 2; ++bj) { f32x4 v0 = acc[ai][bj][m][0] + bv[bj][0], v1 = acc[ai][bj][m][1] + bv[bj][1];
                        if (t < 2) { v0 = gelu4(v0); v1 = gelu4(v1); } else { v0 = sigm4(v0); v1 = sigm4(v1); }
                        *(u32x4*)(rowp + bj * HALF) = pack8(v0, v1); } }
        }
    }
};
template <int MODE> struct EpiGate {
    static constexpr bool PERM = true, AFTER_DRAIN = false;
    bf16_t* O; const bf16_t* Gt; const float* bias;
    __device__ __forceinline__ void operator()(const f32x4 (&acc)[2][2][4][2], const Unit& u, int wr, int wc, int fr, int fq) const {
        const int row0 = u.row0 + wr * 64 + fr, col0 = u.pn * BM + wc * 32 + 8 * fq;
        f32x4 bv[2][2];
#pragma unroll
        for (int bj = 0; bj < 2; ++bj)
#pragma unroll
            for (int n = 0; n < 2; ++n) bv[bj][n] = *(const f32x4*)(bias + col0 + bj * HALF + 4 * n);
#pragma unroll
        for (int ai = 0; ai < 2; ++ai)
#pragma unroll
            for (int m = 0; m < 4; ++m) { const size_t off = (size_t)(row0 + ai * HALF + m * 16) * LDC + col0;
#pragma unroll
                for (int bj = 0; bj < 2; ++bj) { f32x4 g0, g1; unpack8(*(const u32x4*)(Gt + off + bj * HALF), g0, g1);
                    f32x4 v0 = (acc[ai][bj][m][0] + bv[bj][0]) * g0, v1 = (acc[ai][bj][m][1] + bv[bj][1]) * g1;
                    if (MODE == 1) { f32x4 o0, o1; unpack8(*(const u32x4*)(O + off + bj * HALF), o0, o1); v0 += o0; v1 += o1; }
                    *(u32x4*)(O + off + bj * HALF) = pack8(v0, v1); } }
    }
};
struct EpiRes {
    static constexpr bool PERM = false, AFTER_DRAIN = false;
    const float* x; float* S; const float* bias; const float* gate; float alpha;
    __device__ __forceinline__ void operator()(const f32x4 (&acc)[2][2][4][2], const Unit& u, int wr, int wc, int fr, int fq) const {
        const int row0 = u.row0 + wr * 64 + fr, col0 = u.pn * BM + wc * 32 + 4 * fq; const float* gp = gate + (size_t)(u.row0 >> 12) * 6144;
        f32x4 bv[2][2], gv[2][2];
#pragma unroll
        for (int bj = 0; bj < 2; ++bj)
#pragma unroll
            for (int n = 0; n < 2; ++n) { bv[bj][n] = *(const f32x4*)(bias + col0 + bj * HALF + n * 16); gv[bj][n] = *(const f32x4*)(gp + col0 + bj * HALF + n * 16); }
#pragma unroll
        for (int ai = 0; ai < 2; ++ai)
#pragma unroll
            for (int m = 0; m < 4; ++m) { const size_t off = (size_t)(row0 + ai * HALF + m * 16) * LDC + col0;
#pragma unroll
                for (int bj = 0; bj < 2; ++bj)
#pragma unroll
                    for (int n = 0; n < 2; ++n) { const f32x4 xv = *(const f32x4*)(x + off + bj * HALF + n * 16);
                        *(f32x4*)(S + off + bj * HALF + n * 16) = xv * alpha + gv[bj][n] * (acc[ai][bj][m][n] + bv[bj][n]); } }
    }
};
struct EpiSwiglu {
    static constexpr bool PERM = true, AFTER_DRAIN = false;
    bf16_t* ACT; const float* bias;
    __device__ __forceinline__ void operator()(const f32x4 (&acc)[2][2][4][2], const Unit& u, int wr, int wc, int fr, int fq) const {
        const int rl0 = wr * 64 + fr, bcol0 = u.pn * BM + wc * 32 + 8 * fq, col0 = u.pn * HALF + wc * 32 + 8 * fq; const float* bp = bias + (size_t)u.e * 2048;
        f32x4 bv[2][2];
#pragma unroll
        for (int bj = 0; bj < 2; ++bj)
#pragma unroll
            for (int n = 0; n < 2; ++n) bv[bj][n] = *(const f32x4*)(bp + bcol0 + bj * HALF + 4 * n);
#pragma unroll
        for (int ai = 0; ai < 2; ++ai)
#pragma unroll
            for (int m = 0; m < 4; ++m) { const int rl = rl0 + ai * HALF + m * 16;
                f32x4 o[2];
#pragma unroll
                for (int n = 0; n < 2; ++n) { const f32x4 gl = acc[ai][0][m][n] + bv[0][n], li = acc[ai][1][m][n] + bv[1][n];
#pragma unroll
                    for (int j = 0; j < 4; ++j) { const float g = fminf(gl[j], 7.0f), l = fminf(fmaxf(li[j], -7.0f), 7.0f); o[n][j] = g * sigm(1.702f * g) * (l + 1.0f); } }
                if (rl < u.nvalid) *(u32x4*)(ACT + (size_t)(u.row0 + rl) * LDC + col0) = pack8(o[0], o[1]); }
    }
};
struct EpiDown {
    static constexpr bool PERM = true, AFTER_DRAIN = false;
    bf16_t* Y; const float* bias;
    __device__ __forceinline__ void operator()(const f32x4 (&acc)[2][2][4][2], const Unit& u, int wr, int wc, int fr, int fq) const {
        const int rl0 = wr * 64 + fr, col0 = u.pn * BM + wc * 32 + 8 * fq; const float* bp = bias + (size_t)u.e * 1024;
        f32x4 bv[2][2];
#pragma unroll
        for (int bj = 0; bj < 2; ++bj)
#pragma unroll
            for (int n = 0; n < 2; ++n) bv[bj][n] = *(const f32x4*)(bp + col0 + bj * HALF + 4 * n);
#pragma unroll
        for (int ai = 0; ai < 2; ++ai)
#pragma unroll
            for (int m = 0; m < 4; ++m) { const int rl = rl0 + ai * HALF + m * 16;
                if (rl < u.nvalid) { bf16_t* rowp = Y + (size_t)(u.row0 + rl) * LDC + col0;
#pragma unroll
                    for (int bj = 0; bj < 2; ++bj) *(u32x4*)(rowp + bj * HALF) = pack8(acc[ai][bj][m][0] + bv[bj][0], acc[ai][bj][m][1] + bv[bj][1]); } }
    }
};

template <class Epi, class Sched, bool ALIGN_EPI = false, bool SP2 = false>
__device__ __forceinline__ void gemm_phase(PG8_LAS unsigned char* lds, const int K, const Sched& S, const Epi& E) {
    const int tid = threadIdx.x, wid = __builtin_amdgcn_readfirstlane(tid >> 6), lane = tid & 63, wr = wid >> 2, wc = wid & 3, fr = lane & 15, fq = lane >> 4;
    const int nt = K / BK;
    unsigned voffA[2], voffB[2];
#pragma unroll
    for (int i = 0; i < 2; ++i) { int R, C; stage_rc(tid * 16 + i * 8192, R, C); const int Rb = Epi::PERM ? ((R & ~31) + perm32(R & 31)) : R;
        voffA[i] = (unsigned)(R * K + C) * 2u; voffB[i] = (unsigned)(Rb * K + C) * 2u; }
    const size_t kstep = (size_t)(BK * 2);
    const size_t hstep = (size_t)HALF * K * 2;
    const unsigned ldsw = (unsigned)wid * 1024u;
    const int aoff = lds_byte(wr * 64 + fr, fq * 8), boff = lds_byte(wc * 32 + fr, fq * 8);
#define PG8_SA(b, h) (((b) * 2 + (h)) * HTB)
#define PG8_SB(b, h) ((4 + (b) * 2 + (h)) * HTB)
#define PG8_STAGE(bufoff, gbase, voff) do { _Pragma("unroll") for (int _i = 0; _i < 2; ++_i) \
        __builtin_amdgcn_global_load_lds((const unsigned*)((const char*)(gbase) + (voff)[_i]), (PG8_LAS unsigned*)(lds + (bufoff) + ldsw + _i * 8192), 16, 0, 0); } while (0)
#define PG8_LDA(dst, b, h) do { _Pragma("unroll") for (int m = 0; m < 4; ++m) _Pragma("unroll") for (int k = 0; k < 2; ++k) dst[m][k] = *(const PG8_LAS bf16x8*)(lds + PG8_SA(b, h) + aoff + m * 2048 + k * 1024); } while (0)
#define PG8_LDB(dst, b, h) do { _Pragma("unroll") for (int n = 0; n < 2; ++n) _Pragma("unroll") for (int k = 0; k < 2; ++k) dst[n][k] = *(const PG8_LAS bf16x8*)(lds + PG8_SB(b, h) + boff + n * 2048 + k * 1024); } while (0)
#define PG8_MMA(ai, bj, At, Bt) do { __builtin_amdgcn_s_setprio(1); _Pragma("unroll") for (int m = 0; m < 4; ++m) _Pragma("unroll") for (int n = 0; n < 2; ++n) _Pragma("unroll") for (int k = 0; k < 2; ++k) \
        acc[ai][bj][m][n] = __builtin_amdgcn_mfma_f32_16x16x32_bf16(Bt[n][k], At[m][k], acc[ai][bj][m][n], 0, 0, 0); __builtin_amdgcn_s_setprio(0); } while (0)
#define PG8_WAIT_V(n) asm volatile("s_waitcnt vmcnt(" #n ")" ::: "memory")
#define PG8_WAIT_L(n) asm volatile("s_waitcnt lgkmcnt(" #n ")" ::: "memory")
#define PG8_BAR __builtin_amdgcn_s_barrier()
#define PG8_SCHED __builtin_amdgcn_sched_barrier(0)
    Unit cur, nxt; int ui = 0;
    if (!S.next(0, cur)) return;
    f32x4 acc[2][2][4][2];
#pragma unroll
    for (int a = 0; a < 2; ++a)
#pragma unroll
        for (int b = 0; b < 2; ++b)
#pragma unroll
            for (int m = 0; m < 4; ++m)
#pragma unroll
                for (int n = 0; n < 2; ++n) acc[a][b][m][n] = (f32x4){0.f, 0.f, 0.f, 0.f};
    bf16x8 At[4][2], B0[2][2], B1[2][2];
    const char* cA = S.abase(cur); const char* cB = S.bbase(cur);
    S.a_ready(cur);
    if constexpr (SP2) {
        PG8_STAGE(PG8_SB(0, 0), cB, voffB); PG8_STAGE(PG8_SB(0, 1), cB + hstep, voffB); PG8_STAGE(PG8_SA(0, 0), cA, voffA); PG8_STAGE(PG8_SA(0, 1), cA + hstep, voffA);
        if (wr == 1) PG8_BAR;
        PG8_WAIT_V(2); PG8_BAR;
        PG8_STAGE(PG8_SB(1, 0), cB + kstep, voffB); PG8_STAGE(PG8_SA(1, 0), cA + kstep, voffA); PG8_STAGE(PG8_SB(1, 1), cB + hstep + kstep, voffB);
        PG8_WAIT_V(6); PG8_BAR;
    } else {
        PG8_STAGE(PG8_SB(0, 0), cB, voffB); PG8_STAGE(PG8_SA(0, 0), cA, voffA); PG8_STAGE(PG8_SB(0, 1), cB + hstep, voffB); PG8_STAGE(PG8_SA(0, 1), cA + hstep, voffA);
        if (wr == 1) PG8_BAR;
        PG8_WAIT_V(4); PG8_BAR;
        PG8_STAGE(PG8_SB(1, 0), cB + kstep, voffB); PG8_STAGE(PG8_SA(1, 0), cA + kstep, voffA); PG8_STAGE(PG8_SB(1, 1), cB + hstep + kstep, voffB);
        PG8_WAIT_V(6); PG8_BAR;
    }
    for (;;) {
        const bool has_next = S.next(ui + 1, nxt);
        const char* nA = has_next ? S.abase(nxt) : cA; const char* nB = has_next ? S.bbase(nxt) : cB;
        for (int t = 0; t < nt; t += 2) {
            const bool last = (t == nt - 2);
            const char* a1 = cA + (size_t)(t + 1) * kstep;
            const char* a2 = last ? nA : cA + (size_t)(t + 2) * kstep; const char* b2 = last ? nB : cB + (size_t)(t + 2) * kstep;
            const char* a3 = a2 + kstep; const char* b3 = b2 + kstep;
            if (last && has_next) S.a_ready(nxt);
            if constexpr (SP2) {
            PG8_LDB(B0, 0, 0); PG8_LDB(B1, 0, 1); PG8_SCHED; PG8_LDA(At, 0, 0); PG8_STAGE(PG8_SA(1, 1), a1 + hstep, voffA);
            PG8_WAIT_V(8); PG8_WAIT_L(0); PG8_BAR; PG8_MMA(0, 0, At, B0); PG8_MMA(0, 1, At, B1); PG8_BAR; PG8_SCHED;
            PG8_LDA(At, 0, 1); PG8_STAGE(PG8_SB(0, 0), b2, voffB); PG8_STAGE(PG8_SB(0, 1), b2 + hstep, voffB); PG8_STAGE(PG8_SA(0, 0), a2, voffA);
            PG8_WAIT_V(8); PG8_WAIT_L(0); PG8_BAR; PG8_MMA(1, 0, At, B0); PG8_MMA(1, 1, At, B1); PG8_BAR; PG8_SCHED;
            PG8_LDB(B0, 1, 0); PG8_LDB(B1, 1, 1); PG8_SCHED; PG8_LDA(At, 1, 0); PG8_STAGE(PG8_SA(0, 1), a2 + hstep, voffA);
            PG8_WAIT_V(8); PG8_WAIT_L(0); PG8_BAR; PG8_MMA(0, 0, At, B0); PG8_MMA(0, 1, At, B1); PG8_BAR; PG8_SCHED;
            PG8_LDA(At, 1, 1); PG8_STAGE(PG8_SB(1, 0), b3, voffB); PG8_STAGE(PG8_SB(1, 1), b3 + hstep, voffB); PG8_STAGE(PG8_SA(1, 0), a3, voffA);
            PG8_WAIT_V(8); PG8_WAIT_L(0); PG8_BAR; PG8_MMA(1, 0, At, B0); PG8_MMA(1, 1, At, B1); PG8_BAR; PG8_SCHED;
            } else {
            PG8_LDB(B0, 0, 0); PG8_SCHED; PG8_LDA(At, 0, 0); PG8_STAGE(PG8_SA(1, 1), a1 + hstep, voffA);
            PG8_WAIT_L(8); PG8_BAR; PG8_WAIT_L(0); PG8_MMA(0, 0, At, B0); PG8_BAR; PG8_SCHED;
            PG8_LDB(B1, 0, 1); PG8_STAGE(PG8_SB(0, 0), b2, voffB);
            PG8_BAR; PG8_WAIT_L(0); PG8_MMA(0, 1, At, B1); PG8_BAR;
            PG8_LDA(At, 0, 1); PG8_STAGE(PG8_SA(0, 0), a2, voffA);
            PG8_BAR; PG8_WAIT_L(0); PG8_MMA(1, 0, At, B0); PG8_BAR; PG8_SCHED;
            PG8_STAGE(PG8_SB(0, 1), b2 + hstep, voffB);
            PG8_WAIT_V(6); PG8_BAR; PG8_MMA(1, 1, At, B1); PG8_BAR;
            PG8_LDB(B0, 1, 0); PG8_SCHED; PG8_LDA(At, 1, 0); PG8_STAGE(PG8_SA(0, 1), a2 + hstep, voffA);
            PG8_WAIT_L(8); PG8_BAR; PG8_WAIT_L(0); PG8_MMA(0, 0, At, B0); PG8_BAR; PG8_SCHED;
            PG8_LDB(B1, 1, 1); PG8_STAGE(PG8_SB(1, 0), b3, voffB);
            PG8_BAR; PG8_WAIT_L(0); PG8_MMA(0, 1, At, B1); PG8_BAR;
            PG8_LDA(At, 1, 1); PG8_STAGE(PG8_SA(1, 0), a3, voffA);
            PG8_BAR; PG8_WAIT_L(0); PG8_MMA(1, 0, At, B0); PG8_BAR; PG8_SCHED;
            PG8_STAGE(PG8_SB(1, 1), b3 + hstep, voffB);
            PG8_WAIT_V(6); PG8_BAR; PG8_MMA(1, 1, At, B1); PG8_BAR;
            }
        }
        if constexpr (ALIGN_EPI) { if (wr == 0) PG8_BAR; }
        E(acc, cur, wr, wc, fr, fq); S.done(cur);
        if (!has_next) break;
#pragma unroll
        for (int a = 0; a < 2; ++a)
#pragma unroll
            for (int b = 0; b < 2; ++b)
#pragma unroll
                for (int m = 0; m < 4; ++m)
#pragma unroll
                    for (int n = 0; n < 2; ++n) acc[a][b][m][n] = (f32x4){0.f, 0.f, 0.f, 0.f};
        cur = nxt; cA = nA; cB = nB; ++ui;
        if constexpr (ALIGN_EPI) { if (wr == 1) PG8_BAR; }
    }
    PG8_WAIT_V(0);
    if constexpr (!ALIGN_EPI) { if (wr == 0) PG8_BAR; }
    PG8_BAR;
#undef PG8_SA
#undef PG8_SB
#undef PG8_STAGE
#undef PG8_LDA
#undef PG8_LDB
#undef PG8_MMA
#undef PG8_WAIT_V
#undef PG8_WAIT_L
#undef PG8_BAR
#undef PG8_SCHED
}
}

#ifndef PG8_SP2
#define PG8_SP2 true
#endif
#ifndef PG8_ALIGN
#define PG8_ALIGN true
#endif

constexpr int NWAVES = 8;
constexpr int NPH = 11;
constexpr int N_LAUNCHES = MK_N_LAUNCHES;
constexpr int T = 32768, D = 1024, NBATCH = 8, SEQ = 4096, IN_DIM = 6144, NE = 32, TOPK = 4, NMOD = 6144;
constexpr int NASSIGN = T * TOPK;
constexpr float LN_EPS = 1e-5f;
constexpr float DN_ALPHA = 1.189207115002721f;
constexpr int MOD_SHIFT1 = 0, MOD_SCALE1 = 1024, MOD_GATE1 = 2048, MOD_SHIFT2 = 3072, MOD_SCALE2 = 4096, MOD_GATE2 = 5120;

constexpr size_t MiB = 1u << 20;
constexpr size_t WS_CTL = 0, CTL_ZERO_BYTES = 1 * MiB;
constexpr size_t WS_MOD = 1 * MiB;
constexpr size_t WS_BINP = 1 * MiB + 256 * 1024;
constexpr size_t WS_BUPP = 1 * MiB + 320 * 1024;
constexpr size_t WS_WRT = 1 * MiB + 640 * 1024;
constexpr size_t WS_TOKE = 2 * MiB;
constexpr size_t WS_TOKW = 2 * MiB + 512 * 1024;
constexpr size_t WS_TOKR = 3 * MiB;
constexpr size_t WS_LIST = 4 * MiB;
constexpr size_t WS_WIN = 8 * MiB, WS_WPA = 20 * MiB, WS_WPB = 22 * MiB, WS_WOUT = 24 * MiB, WS_WUP = 26 * MiB, WS_WDN = 154 * MiB;
constexpr size_t UB = 64 * MiB;
constexpr size_t WS_R0 = 218 * MiB;
constexpr size_t WS_Z = WS_R0, WS_GU = WS_R0 + UB, WS_GV = WS_R0 + 2 * UB, WS_SGA = WS_R0 + 3 * UB, WS_SGB = WS_R0 + 4 * UB, WS_ACT = WS_R0;
constexpr size_t WS_R1 = 538 * MiB;
constexpr size_t WS_H = WS_R1, WS_AACT = WS_R1 + UB, WS_GATED = WS_R1 + 2 * UB, WS_MERGED = WS_R1 + 3 * UB, WS_XG = WS_R1, WS_Y = WS_R1;
constexpr size_t WS_H2 = 795 * MiB;
constexpr size_t WS_END = 859 * MiB;
static_assert(WS_R0 + 5 * UB <= WS_R1 && WS_R1 + 4 * UB + MiB <= WS_H2 && WS_H2 + UB <= WS_END && WS_WDN + UB <= WS_R0 && WS_WUP + 2 * UB <= WS_WDN, "d_ws map");
static_assert((size_t)(NASSIGN + 256) * 2048 <= 4 * UB + MiB, "ACT / XG with 256 rows of slack");
constexpr int CW_BAR = 4096;
constexpr int CW_ECNT = 16384;

constexpr int RING_OFF = 0, RING_BYTES = 131072;
constexpr int LDSCTL_OFF = RING_BYTES, MISC_OFF = LDSCTL_OFF + 320;
constexpr int TBL_CNT = LDSCTL_OFF + 512, TBL_RS = LDSCTL_OFF + 640, TBL_TPU = LDSCTL_OFF + 784, TBL_TPD = LDSCTL_OFF + 928;
constexpr int RT_CNT = LDSCTL_OFF + 2048, RT_BASE = RT_CNT + 128, RT_RECE = RT_CNT + 256, RT_RECL = RT_RECE + 2048;
constexpr int LDS_BYTES = 147456;

#define GAS __attribute__((address_space(1)))
#define LAS __attribute__((address_space(3)))
typedef unsigned short bf16;
typedef unsigned v4u __attribute__((ext_vector_type(4)));
typedef unsigned v2u __attribute__((ext_vector_type(2)));
typedef float f32x4 __attribute__((ext_vector_type(4)));
typedef float f32x2 __attribute__((ext_vector_type(2)));
typedef short bf16x8 __attribute__((ext_vector_type(8)));
typedef GAS unsigned gu32;
#define RLX_AGENT __ATOMIC_RELAXED, __HIP_MEMORY_SCOPE_AGENT
#define LDS_WAIT() asm volatile("s_waitcnt lgkmcnt(0)" ::: "memory")
#define VM_WAIT() asm volatile("s_waitcnt vmcnt(0)" ::: "memory")
__device__ __forceinline__ unsigned f2bf(float f) { unsigned u = __builtin_bit_cast(unsigned, f); return (u + 0x7fffu + ((u >> 16) & 1u)) >> 16; }
__device__ __forceinline__ unsigned pk2(float lo, float hi) { return f2bf(lo) | (f2bf(hi) << 16); }
__device__ __forceinline__ float bflo(unsigned w) { return __uint_as_float(w << 16); }
__device__ __forceinline__ float bfhi(unsigned w) { return __uint_as_float(w & 0xffff0000u); }

#define XB_TMO      128
#define XB_XCNT(j)  (256  + 64 * (j))
#define XB_XSUB(j)  (1280 + 64 * (j))
#define XB_XGEN(j)  (2304 + 64 * (j))
#define XB_TOP      3328
#define XB_TOPGEN   3392
#define XCD_BAR_WORDS 3456
#define XB_SPIN_CAP (1u << 18)
__device__ __forceinline__ unsigned xb_ld(unsigned* p)              { return __hip_atomic_load(p, __ATOMIC_RELAXED, __HIP_MEMORY_SCOPE_AGENT); }
__device__ __forceinline__ unsigned xb_add(unsigned* p, unsigned v) { return __hip_atomic_fetch_add(p, v, __ATOMIC_RELAXED, __HIP_MEMORY_SCOPE_AGENT); }
__device__ __forceinline__ unsigned xb_xcc_id() { return (unsigned)__builtin_amdgcn_s_getreg((3 << 11) | 20) & 0xFu; }
#define XB_SPIN(cond, bar) do { unsigned _sp = 0; while (cond) { __builtin_amdgcn_s_sleep(1); \
    if ((++_sp & 255u) == 0u) { if (xb_ld(&(bar)[XB_TMO])) break; if (_sp > XB_SPIN_CAP) { atomicAdd(&(bar)[XB_TMO], 1u); break; } } } } while (0)
struct XcdBarrier { unsigned* bar; unsigned x; volatile LAS unsigned* st; };
__device__ __forceinline__ XcdBarrier xcd_barrier_post(unsigned* bar, volatile LAS unsigned* st) {
    XcdBarrier b; b.bar = bar; b.x = xb_xcc_id(); b.st = st;
    if (threadIdx.x == 0) (void)xb_add(&bar[XB_XCNT(b.x)], 1u);
    return b;
}
__device__ __forceinline__ void xcd_barrier_complete(unsigned* bar, unsigned x, unsigned& nloc, unsigned& nx) {
    const unsigned G = gridDim.x * gridDim.y * gridDim.z;
    unsigned sum, cnt, mine, sp = 0u;
    for (;;) {
        sum = 0u; cnt = 0u; mine = 0u;
#pragma unroll
        for (unsigned j = 0; j < 16; ++j) { const unsigned c = xb_ld(&bar[XB_XCNT(j)]); sum += c; cnt += (c > 0u) ? 1u : 0u; mine = (j == x) ? c : mine; }
        if (sum == G) break;
        __builtin_amdgcn_s_sleep(1);
        if ((++sp & 255u) == 0u) { if (xb_ld(&bar[XB_TMO])) break; if (sp > XB_SPIN_CAP) { atomicAdd(&bar[XB_TMO], 1u); break; } }
    }
    nloc = mine > 0u ? mine : 1u; nx = cnt > 0u ? cnt : 1u;
}
__device__ __forceinline__ void xcd_barrier(const XcdBarrier& b) {
    asm volatile("s_waitcnt vmcnt(0)" ::: "memory");
    __syncthreads();
    if (threadIdx.x == 0) {
        unsigned* bar = b.bar;
        __builtin_amdgcn_s_waitcnt(0);
        unsigned nloc = b.st[0], nx = b.st[1];
        if (nloc == 0u) { xcd_barrier_complete(bar, b.x, nloc, nx); b.st[0] = nloc; b.st[1] = nx; }
        const unsigned old = xb_add(&bar[XB_XSUB(b.x)], 1u);
        const unsigned gen = old / nloc;
        if (old + 1u == (gen + 1u) * nloc) {
            __builtin_amdgcn_fence(__ATOMIC_RELEASE, "agent");
            asm volatile("s_waitcnt vmcnt(0)" ::: "memory");
            const unsigned og = xb_add(&bar[XB_TOP], 1u);
            const unsigned tg = og / nx;
            if (og + 1u == (tg + 1u) * nx) xb_add(&bar[XB_TOPGEN], 1u);
            else XB_SPIN(xb_ld(&bar[XB_TOPGEN]) == tg, bar);
            __builtin_amdgcn_fence(__ATOMIC_ACQUIRE, "agent");
            xb_add(&bar[XB_XGEN(b.x)], 1u);
            asm volatile("s_waitcnt vmcnt(0)" ::: "memory");
        } else {
            XB_SPIN(xb_ld(&bar[XB_XGEN(b.x)]) == gen, bar);
            __builtin_amdgcn_fence(__ATOMIC_ACQUIRE, "agent");
            asm volatile("s_waitcnt vmcnt(0)" ::: "memory");
        }
    }
    __syncthreads();
}

struct Frame {
    LAS unsigned char* lds;
    volatile LAS unsigned* MISC;
    gu32* ctl;
    int tid, lane, wave;
    int vcu, G;
    unsigned char* ws;
    const float* in[30]; float* out;
};
enum { I_X = 0, I_C, I_WADA, I_BADA, I_WIN, I_BIN, I_CONVW, I_CONVB, I_LNAG, I_LNAB, I_WPA, I_BPA, I_LNVG, I_LNVB, I_WS, I_BS, I_WPB, I_BPB, I_WOUT, I_BOUT, I_P1G, I_P1B,
       I_WR, I_BR, I_WUP, I_BUP, I_WDN, I_BDN, I_P2G, I_P2B };

__device__ __forceinline__ float wave_sum(float v) {
#pragma unroll
    for (int o = 1; o < 64; o <<= 1) v += __shfl_xor(v, o);
    return v;
}
__device__ __forceinline__ int glu_map(int c) { if (c >= 2048) return c; const int bj = c >> 10, q = c & 1023; return ((q >> 7) << 8) + (bj << 7) + (q & 127); }

__device__ __forceinline__ void p0_transpose_item(const float* W, int K, int N, bf16* WT, int drow0, LAS float* scr, int k0, int n0, int lane) {
#pragma unroll 8
    for (int i = 0; i < 32; ++i) { const int kk = 2 * i + (lane >> 5); scr[kk * 33 + (lane & 31)] = W[(size_t)(k0 + kk) * N + n0 + (lane & 31)]; }
    LDS_WAIT(); asm volatile("" ::: "memory");
    const int c = lane & 7;
#pragma unroll
    for (int j = 0; j < 4; ++j) { const int n = (lane >> 3) + 8 * j; const LAS float* s = scr + (8 * c) * 33 + n;
        v4u o; o.x = pk2(s[0 * 33], s[1 * 33]); o.y = pk2(s[2 * 33], s[3 * 33]); o.z = pk2(s[4 * 33], s[5 * 33]); o.w = pk2(s[6 * 33], s[7 * 33]);
        *(GAS v4u*)(WT + (size_t)(drow0 + n) * K + k0 + 8 * c) = o; }
    LDS_WAIT(); asm volatile("" ::: "memory");
}

__device__ __forceinline__ void p0_prologue(Frame& F) {
    {
        LAS float* cond = (LAS float*)(F.lds + RING_OFF);
        LAS float* red = (LAS float*)(F.lds + RING_OFF + 32768);
        const float* c = F.in[I_C]; const float* wada = F.in[I_WADA]; const float* bada = F.in[I_BADA]; float* mod = (float*)(F.ws + WS_MOD);
        bool loaded = false;
        for (int it = blockIdx.x; it < NMOD / 32; it += F.G) {
            if (!loaded) { for (int i = F.tid; i < NBATCH * D; i += NWAVES * 64) { const float v = c[i]; cond[i] = v / (1.0f + __expf(-v)); } loaded = true; }
            __syncthreads();
            const int col = F.lane & 31, kh = F.lane >> 5, n0 = it * 32;
            float a[NBATCH];
#pragma unroll
            for (int b = 0; b < NBATCH; ++b) a[b] = 0.f;
#pragma unroll 8
            for (int i = 0; i < 64; ++i) { const int k = F.wave * 128 + 2 * i + kh; const float w = wada[(size_t)k * NMOD + n0 + col];
#pragma unroll
                for (int b = 0; b < NBATCH; ++b) a[b] += cond[b * D + k] * w; }
#pragma unroll
            for (int b = 0; b < NBATCH; ++b) { a[b] += __shfl_xor(a[b], 32); if (F.lane < 32) red[(F.wave * NBATCH + b) * 32 + col] = a[b]; }
            __syncthreads();
            if (F.tid < 256) { const int b = F.tid >> 5, cc = F.tid & 31; float s = bada[n0 + cc];
#pragma unroll
                for (int w = 0; w < NWAVES; ++w) s += red[(w * NBATCH + b) * 32 + cc];
                mod[b * NMOD + n0 + cc] = s; }
            __syncthreads();
        }
        __syncthreads();
    }
    {
        const int gt = (F.vcu * NWAVES + F.wave) * 64 + F.lane, NGT = F.G * NWAVES * 64;
        float* binp = (float*)(F.ws + WS_BINP); float* bupp = (float*)(F.ws + WS_BUPP); float* wrt = (float*)(F.ws + WS_WRT);
        for (int i = gt; i < IN_DIM; i += NGT) binp[glu_map(i)] = F.in[I_BIN][i];
        for (int i = gt; i < NE * 2048; i += NGT) { const int e = i >> 11, cc = i & 2047; bupp[e * 2048 + glu_map(cc)] = F.in[I_BUP][i]; }
        for (int i = gt; i < D * NE; i += NGT) { const int cc = i >> 5, e = i & 31; wrt[e * D + cc] = F.in[I_WR][i]; }
    }
    {
        LAS float* scr = (LAS float*)(F.lds + RING_OFF + F.wave * 16384);
        const int gw = F.vcu * NWAVES + F.wave, NGW = F.G * NWAVES;
        constexpr int I_IN = 16 * 192, I_SQ = 16 * 32, I_UP = NE * 16 * 64, I_DN = NE * 16 * 32;
        constexpr int NITEMS = I_IN + 3 * I_SQ + I_UP + I_DN;
        for (int it = gw; it < NITEMS; it += NGW) {
            int r = it;
            if (r < I_IN) { const int kb = r / 192, nb = r % 192; p0_transpose_item(F.in[I_WIN], D, IN_DIM, (bf16*)(F.ws + WS_WIN), glu_map(32 * nb), scr, 64 * kb, 32 * nb, F.lane); continue; } r -= I_IN;
            if (r < I_SQ) { const int kb = r / 32, nb = r % 32; p0_transpose_item(F.in[I_WPA], D, D, (bf16*)(F.ws + WS_WPA), 32 * nb, scr, 64 * kb, 32 * nb, F.lane); continue; } r -= I_SQ;
            if (r < I_SQ) { const int kb = r / 32, nb = r % 32; p0_transpose_item(F.in[I_WPB], D, D, (bf16*)(F.ws + WS_WPB), 32 * nb, scr, 64 * kb, 32 * nb, F.lane); continue; } r -= I_SQ;
            if (r < I_SQ) { const int kb = r / 32, nb = r % 32; p0_transpose_item(F.in[I_WOUT], D, D, (bf16*)(F.ws + WS_WOUT), 32 * nb, scr, 64 * kb, 32 * nb, F.lane); continue; } r -= I_SQ;
            if (r < I_UP) { const int e = r >> 10, rr = r & 1023, kb = rr >> 6, nb = rr & 63;
                p0_transpose_item(F.in[I_WUP] + (size_t)e * D * 2048, D, 2048, (bf16*)(F.ws + WS_WUP) + (size_t)e * 2048 * D, glu_map(32 * nb), scr, 64 * kb, 32 * nb, F.lane); continue; } r -= I_UP;
            { const int e = r >> 9, rr = r & 511, kb = rr >> 5, nb = rr & 31;
                p0_transpose_item(F.in[I_WDN] + (size_t)e * D * D, D, D, (bf16*)(F.ws + WS_WDN) + (size_t)e * D * D, 32 * nb, scr, 64 * kb, 32 * nb, F.lane); }
        }
    }
}

__device__ __forceinline__ void p1_lnmod(Frame& F) {
    const int gw = F.vcu * NWAVES + F.wave, NGW = F.G * NWAVES, RPW = (T + NGW - 1) / NGW;
    const int r0 = gw * RPW, r1 = (r0 + RPW) < T ? (r0 + RPW) : T;
    const float* mod = (const float*)(F.ws + WS_MOD); bf16* H = (bf16*)(F.ws + WS_H);
    int curb = -1; f32x4 sc[4], sh[4];
    for (int r = r0; r < r1; ++r) {
        const int b = r >> 12;
        if (b != curb) { curb = b;
#pragma unroll
            for (int j = 0; j < 4; ++j) { sc[j] = *(const f32x4*)(mod + b * NMOD + MOD_SCALE1 + 4 * F.lane + 256 * j) + 1.0f; sh[j] = *(const f32x4*)(mod + b * NMOD + MOD_SHIFT1 + 4 * F.lane + 256 * j); } }
        const f32x4* xr = (const f32x4*)(F.in[I_X] + (size_t)r * D) + F.lane;
        f32x4 v[4]; float s = 0.f;
#pragma unroll
        for (int j = 0; j < 4; ++j) { v[j] = xr[64 * j]; s += (v[j].x + v[j].y) + (v[j].z + v[j].w); }
        const float mean = wave_sum(s) * (1.f / D); float s2 = 0.f;
#pragma unroll
        for (int j = 0; j < 4; ++j) { v[j] = v[j] - mean; s2 += (v[j].x * v[j].x + v[j].y * v[j].y) + (v[j].z * v[j].z + v[j].w * v[j].w); }
        const float rstd = 1.f / sqrtf(wave_sum(s2) * (1.f / D) + LN_EPS);
        v2u* o8 = (v2u*)(H + (size_t)r * D) + F.lane;
#pragma unroll
        for (int j = 0; j < 4; ++j) { const f32x4 h = v[j] * rstd * sc[j] + sh[j]; v2u o; o.x = pk2(h.x, h.y); o.y = pk2(h.z, h.w); o8[64 * j] = o; }
    }
}

__device__ __forceinline__ void p3_conv_unit(Frame& F, int u) {
    const int c0 = 2 * F.tid, g0 = u * 128, t0 = (u & 31) * 128;
    const bf16* Z = (const bf16*)(F.ws + WS_Z); bf16* AACT = (bf16*)(F.ws + WS_AACT);
    LAS float* wl = (LAS float*)(F.lds + RING_OFF);
    LAS float* red = (LAS float*)(F.lds + RING_OFF + 126976);
    for (int i = F.tid; i < 31 * D / 4; i += NWAVES * 64) ((LAS f32x4*)wl)[i] = ((const f32x4*)F.in[I_CONVW])[i];
    __syncthreads();
    unsigned wa_off = (unsigned)(RING_OFF + c0 * 4), wb_off = (unsigned)(RING_OFF + 16 * D * 4 + c0 * 4);
    asm volatile("" : "+v"(wa_off), "+v"(wb_off));
    const LAS unsigned char* wA = F.lds + wa_off; const LAS unsigned char* wB = F.lds + wb_off;
    const f32x2 cb = *(const f32x2*)(F.in[I_CONVB] + c0), lg = *(const f32x2*)(F.in[I_LNAG] + c0), lb = *(const f32x2*)(F.in[I_LNAB] + c0);
    float z0[38], z1[38];
    { const bf16* zh = Z + (size_t)(t0 > 0 ? g0 - 30 : g0) * D + c0; const unsigned msk = t0 > 0 ? 0xffffffffu : 0u;
#pragma unroll
      for (int i = 0; i < 30; ++i) { const unsigned p = *(const unsigned*)(zh + (size_t)i * D) & msk; z0[i] = bflo(p); z1[i] = bfhi(p); } }
#pragma unroll 1
    for (int ch = 0; ch < 16; ++ch) {
        const bf16* zr = Z + (size_t)(g0 + ch * 8) * D + c0; bf16* orow = AACT + (size_t)(g0 + ch * 8) * D + c0;
#pragma unroll
        for (int r = 0; r < 8; ++r) { const unsigned p = *(const unsigned*)(zr + (size_t)r * D); z0[30 + r] = bflo(p); z1[30 + r] = bfhi(p); }
        float o0[8], o1[8], sv[16];
#pragma unroll
        for (int r = 0; r < 8; ++r) { o0[r] = cb.x; o1[r] = cb.y; }
#pragma unroll
        for (int j = 0; j < 31; ++j) { const f32x2 w = (j < 16) ? *(const LAS f32x2*)(wA + j * D * 4) : *(const LAS f32x2*)(wB + (j - 16) * D * 4);
#pragma unroll
            for (int r = 0; r < 8; ++r) { o0[r] += w.x * z0[r + j]; o1[r] += w.y * z1[r + j]; }
            if ((j & 3) == 3) __builtin_amdgcn_sched_barrier(0); }
#pragma unroll
        for (int r = 0; r < 8; ++r) { sv[r] = o0[r] + o1[r]; sv[8 + r] = o0[r] * o0[r] + o1[r] * o1[r]; }
        LAS float* rd = red + (ch & 1) * 128;
#pragma unroll
        for (int v = 0; v < 16; ++v) { const float s = wave_sum(sv[v]); if (F.lane == v) rd[F.wave * 16 + v] = s; }
        __syncthreads();
        float tot[16];
#pragma unroll
        for (int v = 0; v < 16; ++v) tot[v] = 0.f;
#pragma unroll
        for (int w = 0; w < NWAVES; ++w)
#pragma unroll
            for (int v4 = 0; v4 < 4; ++v4) { const f32x4 q = *(const LAS f32x4*)(rd + w * 16 + 4 * v4); tot[4 * v4] += q.x; tot[4 * v4 + 1] += q.y; tot[4 * v4 + 2] += q.z; tot[4 * v4 + 3] += q.w; }
#pragma unroll
        for (int r = 0; r < 8; ++r) { const float mean = tot[r] * (1.f / D), var = tot[8 + r] * (1.f / D) - mean * mean, rstd = 1.f / sqrtf(fmaxf(var, 0.f) + LN_EPS);
            const float y0 = (o0[r] - mean) * rstd * lg.x + lb.x, y1 = (o1[r] - mean) * rstd * lg.y + lb.y;
            *(unsigned*)(orow + (size_t)r * D) = pk2(y0 * pg8::sigm(y0), y1 * pg8::sigm(y1)); }
#pragma unroll
        for (int i = 0; i < 30; ++i) { z0[i] = z0[i + 8]; z1[i] = z1[i + 8]; }
    }
    __syncthreads();
}

__device__ __forceinline__ void p3_mix_unit(Frame& F, int u) {
    constexpr int LP = 136;
    LAS unsigned short* Wl = (LAS unsigned short*)(F.lds + RING_OFF);
    LAS unsigned short* Vt = (LAS unsigned short*)(F.lds + RING_OFF + 34816);
    LAS float* st = (LAS float*)(F.lds + RING_OFF + 69632);
    const bf16* GV = (const bf16*)(F.ws + WS_GV); const bf16* GU = (const bf16*)(F.ws + WS_GU); bf16* GATED = (bf16*)(F.ws + WS_GATED);
    const int g0 = u * 128, fr = F.lane & 15, fq = F.lane >> 4;
    for (int i = 0; i < 16; ++i) { const int s = F.wave * 16 + i; const bf16* row = GV + (size_t)(g0 + s) * D;
        const v4u a = *(const v4u*)(row + 8 * F.lane), b = *(const v4u*)(row + 512 + 8 * F.lane);
        float sm = 0.f, sq = 0.f;
#pragma unroll
        for (int j = 0; j < 4; ++j) { const float x0 = bflo(a[j]), x1 = bfhi(a[j]), x2 = bflo(b[j]), x3 = bfhi(b[j]); sm += (x0 + x1) + (x2 + x3); sq += (x0 * x0 + x1 * x1) + (x2 * x2 + x3 * x3); }
        sm = wave_sum(sm); sq = wave_sum(sq);
        const float mu = sm * (1.f / D), var = sq * (1.f / D) - mu * mu;
        if (F.lane == 0) { st[s] = mu; st[128 + s] = 1.f / sqrtf(fmaxf(var, 0.f) + LN_EPS); } }
    __syncthreads();
    for (int h = 0; h < 8; ++h) {
        const float* wsrc = F.in[I_WS] + (size_t)h * 16384;
#pragma unroll
        for (int i = 0; i < 8; ++i) { const int idx = F.tid + 512 * i, t = idx >> 5, s4 = (idx & 31) * 4; f32x4 w = *(const f32x4*)(wsrc + t * 128 + s4);
            w.x = (s4 + 0 <= t) ? w.x : 0.f; w.y = (s4 + 1 <= t) ? w.y : 0.f; w.z = (s4 + 2 <= t) ? w.z : 0.f; w.w = (s4 + 3 <= t) ? w.w : 0.f;
            v2u o; o.x = pk2(w.x, w.y); o.y = pk2(w.z, w.w); *(LAS v2u*)(Wl + t * LP + s4) = o; }
        {
            const int p = F.lane; const float mua = st[2 * p], rsa = st[128 + 2 * p], mub = st[2 * p + 1], rsb = st[128 + 2 * p + 1];
#pragma unroll
            for (int i = 0; i < 2; ++i) { const int d0 = (F.wave * 2 + i) * 8, cg = h * 128 + d0;
                const v4u ra = *(const v4u*)(GV + (size_t)(g0 + 2 * p) * D + cg), rb = *(const v4u*)(GV + (size_t)(g0 + 2 * p + 1) * D + cg);
                const f32x4 g0v = *(const f32x4*)(F.in[I_LNVG] + cg), g1v = *(const f32x4*)(F.in[I_LNVG] + cg + 4), b0v = *(const f32x4*)(F.in[I_LNVB] + cg), b1v = *(const f32x4*)(F.in[I_LNVB] + cg + 4);
#pragma unroll
                for (int j = 0; j < 8; ++j) { const unsigned wa = ra[j >> 1], wb = rb[j >> 1]; const float xa = (j & 1) ? bfhi(wa) : bflo(wa), xb = (j & 1) ? bfhi(wb) : bflo(wb);
                    const float g = j < 4 ? g0v[j & 3] : g1v[j & 3], bb = j < 4 ? b0v[j & 3] : b1v[j & 3];
                    const float na = (xa - mua) * rsa * g + bb, nb = (xb - mub) * rsb * g + bb;
                    *(LAS unsigned*)(Vt + (d0 + j) * LP + 2 * p) = pk2(na, nb); } }
        }
        __syncthreads();
        f32x4 acc[8];
#pragma unroll
        for (int dn = 0; dn < 8; ++dn) acc[dn] = (f32x4){0.f, 0.f, 0.f, 0.f};
        const int ksmax = F.wave >> 1;
        for (int ks = 0; ks <= ksmax; ++ks) {
            const bf16x8 wf = *(const LAS bf16x8*)(Wl + (16 * F.wave + fr) * LP + 32 * ks + 8 * fq);
#pragma unroll
            for (int dn = 0; dn < 8; ++dn) { const bf16x8 vf = *(const LAS bf16x8*)(Vt + (16 * dn + fr) * LP + 32 * ks + 8 * fq);
                acc[dn] = __builtin_amdgcn_mfma_f32_16x16x32_bf16(vf, wf, acc[dn], 0, 0, 0); }
        }
        const int t = 16 * F.wave + fr; const float bs = F.in[I_BS][h * 128 + t];
#pragma unroll
        for (int dn = 0; dn < 8; ++dn) { const size_t off = (size_t)(g0 + t) * D + h * 128 + 16 * dn + 4 * fq; const v2u gu = *(const v2u*)(GU + off);
            v2u o; o.x = pk2((acc[dn][0] + bs) * bflo(gu.x), (acc[dn][1] + bs) * bfhi(gu.x)); o.y = pk2((acc[dn][2] + bs) * bflo(gu.y), (acc[dn][3] + bs) * bfhi(gu.y));
            *(v2u*)(GATED + off) = o; }
        __syncthreads();
    }
}

__device__ __forceinline__ void moe_tables(Frame& F) {
    LAS int* cnt = (LAS int*)(F.lds + TBL_CNT); LAS int* rs = (LAS int*)(F.lds + TBL_RS); LAS int* tpu = (LAS int*)(F.lds + TBL_TPU); LAS int* tpd = (LAS int*)(F.lds + TBL_TPD);
    if (F.tid == 0) { int r = 0, a = 0, b = 0;
        for (int e = 0; e < NE; ++e) { const int c = (int)__hip_atomic_load(F.ctl + CW_ECNT + e, RLX_AGENT); const int tiles = (c + 255) >> 8; cnt[e] = c; rs[e] = r; tpu[e] = a; tpd[e] = b; r += c; a += tiles * 8; b += tiles * 4; }
        rs[NE] = r; tpu[NE] = a; tpd[NE] = b; }
    __syncthreads();
}

__device__ __forceinline__ void p6_router(Frame& F) {
    LAS float* wr = (LAS float*)(F.lds + RING_OFF);
    LAS int* lcnt = (LAS int*)(F.lds + RT_CNT); LAS int* lbase = (LAS int*)(F.lds + RT_BASE); LAS int* rece = (LAS int*)(F.lds + RT_RECE); LAS int* recl = (LAS int*)(F.lds + RT_RECL);
    const float* mod = (const float*)(F.ws + WS_MOD); bf16* H2 = (bf16*)(F.ws + WS_H2);
    int* toke = (int*)(F.ws + WS_TOKE); float* tokw = (float*)(F.ws + WS_TOKW); int* tokr = (int*)(F.ws + WS_TOKR); int* list = (int*)(F.ws + WS_LIST);
    { const f32x4* src = (const f32x4*)(F.ws + WS_WRT); for (int i = F.tid; i < NE * D / 4; i += NWAVES * 64) ((LAS f32x4*)wr)[i] = src[i]; }
    for (int rb = blockIdx.x; rb < T / 128; rb += F.G) {
        if (F.tid < NE) lcnt[F.tid] = 0;
        __syncthreads();
        const int b = (rb * 128) >> 12;
        for (int pr = 0; pr < 8; ++pr) {
            const int rl0 = F.wave * 16 + 2 * pr;
            f32x4 h[2][4];
#pragma unroll
            for (int q = 0; q < 2; ++q) {
                const int r = rb * 128 + rl0 + q; f32x4* sr = (f32x4*)(F.out + (size_t)r * D) + F.lane;
                f32x4 v[4]; float s = 0.f;
#pragma unroll
                for (int j = 0; j < 4; ++j) { v[j] = sr[64 * j]; s += (v[j].x + v[j].y) + (v[j].z + v[j].w); }
                float mean = wave_sum(s) * (1.f / D), s2 = 0.f;
#pragma unroll
                for (int j = 0; j < 4; ++j) { v[j] = v[j] - mean; s2 += (v[j].x * v[j].x + v[j].y * v[j].y) + (v[j].z * v[j].z + v[j].w * v[j].w); }
                float rstd = 1.f / sqrtf(wave_sum(s2) * (1.f / D) + LN_EPS);
                s = 0.f;
#pragma unroll
                for (int j = 0; j < 4; ++j) { const f32x4 g = *(const f32x4*)(F.in[I_P1G] + 4 * F.lane + 256 * j), bb = *(const f32x4*)(F.in[I_P1B] + 4 * F.lane + 256 * j);
                    v[j] = v[j] * rstd * g + bb; sr[64 * j] = v[j]; s += (v[j].x + v[j].y) + (v[j].z + v[j].w); }
                mean = wave_sum(s) * (1.f / D); s2 = 0.f;
#pragma unroll
                for (int j = 0; j < 4; ++j) { v[j] = v[j] - mean; s2 += (v[j].x * v[j].x + v[j].y * v[j].y) + (v[j].z * v[j].z + v[j].w * v[j].w); }
                rstd = 1.f / sqrtf(wave_sum(s2) * (1.f / D) + LN_EPS);
                v2u* o8 = (v2u*)(H2 + (size_t)r * D) + F.lane;
#pragma unroll
                for (int j = 0; j < 4; ++j) { const f32x4 sc = *(const f32x4*)(mod + b * NMOD + MOD_SCALE2 + 4 * F.lane + 256 * j) + 1.0f, sh = *(const f32x4*)(mod + b * NMOD + MOD_SHIFT2 + 4 * F.lane + 256 * j);
                    h[q][j] = v[j] * rstd * sc + sh; v2u o; o.x = pk2(h[q][j].x, h[q][j].y); o.y = pk2(h[q][j].z, h[q][j].w); o8[64 * j] = o; }
            }
            float lg[64];
#pragma unroll
            for (int e = 0; e < NE; ++e) { float a0 = 0.f, a1 = 0.f;
#pragma unroll
                for (int j = 0; j < 4; ++j) { const f32x4 w = *(const LAS f32x4*)(wr + e * D + 4 * F.lane + 256 * j);
                    a0 += (h[0][j].x * w.x + h[0][j].y * w.y) + (h[0][j].z * w.z + h[0][j].w * w.w); a1 += (h[1][j].x * w.x + h[1][j].y * w.y) + (h[1][j].z * w.z + h[1][j].w * w.w); }
                lg[e] = a0; lg[32 + e] = a1; }
#pragma unroll
            for (int o = 32; o >= 1; o >>= 1) { const bool up = (F.lane & o) != 0;
#pragma unroll
                for (int k = 0; k < o; ++k) { const float keep = up ? lg[k + o] : lg[k], give = up ? lg[k] : lg[k + o]; lg[k] = keep + __shfl_xor(give, o); } }
            const int e = F.lane & 31, q = F.lane >> 5; const float logit = lg[0] + F.in[I_BR][e];
            float tv[4]; int ti[4]; bool sel = false; int myk = 0;
#pragma unroll
            for (int k = 0; k < 4; ++k) { float cv = sel ? -3.0e38f : logit; int ci = e;
#pragma unroll
                for (int o = 16; o >= 1; o >>= 1) { const float ov = __shfl_xor(cv, o); const int oi = __shfl_xor(ci, o); if (ov > cv || (ov == cv && oi < ci)) { cv = ov; ci = oi; } }
                tv[k] = cv; ti[k] = ci; if (ci == e) { sel = true; myk = k; } }
            const float p1 = __expf(tv[1] - tv[0]), p2 = __expf(tv[2] - tv[0]), p3 = __expf(tv[3] - tv[0]), inv = 1.0f / (1.0f + p1 + p2 + p3);
            if (sel) { const float wk = (myk == 0 ? 1.0f : (myk == 1 ? p1 : (myk == 2 ? p2 : p3))) * inv; const int r = rb * 128 + rl0 + q;
                const int lr = __hip_atomic_fetch_add(lcnt + e, 1, __ATOMIC_RELAXED, __HIP_MEMORY_SCOPE_WORKGROUP);
                rece[(rl0 + q) * 4 + myk] = e; recl[(rl0 + q) * 4 + myk] = lr; toke[r * 4 + myk] = e; tokw[r * 4 + myk] = wk; }
        }
        __syncthreads();
        if (F.tid < NE) lbase[F.tid] = (int)__hip_atomic_fetch_add(F.ctl + CW_ECNT + F.tid, (unsigned)lcnt[F.tid], RLX_AGENT);
        __syncthreads();
        { const int i = F.tid; const int e = rece[i], rank = lbase[e] + recl[i], r = rb * 128 + (i >> 2); tokr[r * 4 + (i & 3)] = rank; list[(size_t)e * T + rank] = r; }
        __syncthreads();
    }
}

__device__ __forceinline__ void p7_gather(Frame& F) {
    const LAS int* rs = (const LAS int*)(F.lds + TBL_RS); const int* list = (const int*)(F.ws + WS_LIST);
    const bf16* H2 = (const bf16*)(F.ws + WS_H2); bf16* XG = (bf16*)(F.ws + WS_XG);
    const int gw = F.vcu * NWAVES + F.wave, NGW = F.G * NWAVES;
    for (int p = gw; p < NASSIGN; p += NGW) {
        int e = 0;
#pragma unroll
        for (int j = 1; j < NE; ++j) e += (p >= rs[j]) ? 1 : 0;
        const int tok = list[(size_t)e * T + (p - rs[e])];
        const v4u* src = (const v4u*)(H2 + (size_t)tok * D); v4u* dst = (v4u*)(XG + (size_t)p * D);
        const v4u a = src[F.lane], b = src[64 + F.lane]; dst[F.lane] = a; dst[64 + F.lane] = b;
    }
}

__device__ __forceinline__ void p10_combine(Frame& F) {
    const LAS int* rs = (const LAS int*)(F.lds + TBL_RS);
    const int gw = F.vcu * NWAVES + F.wave, NGW = F.G * NWAVES, RPW = (T + NGW - 1) / NGW;
    const int r0 = gw * RPW, r1 = (r0 + RPW) < T ? (r0 + RPW) : T;
    const float* mod = (const float*)(F.ws + WS_MOD); const bf16* Y = (const bf16*)(F.ws + WS_Y);
    const int* toke = (const int*)(F.ws + WS_TOKE); const float* tokw = (const float*)(F.ws + WS_TOKW); const int* tokr = (const int*)(F.ws + WS_TOKR);
    for (int r = r0; r < r1; ++r) {
        const int b = r >> 12;
        const int ev = toke[r * 4 + (F.lane & 3)], rv = tokr[r * 4 + (F.lane & 3)]; const float wv = tokw[r * 4 + (F.lane & 3)];
        const int yrow_l = rs[ev] + rv;
        f32x4 y[4];
#pragma unroll
        for (int j = 0; j < 4; ++j) y[j] = (f32x4){0.f, 0.f, 0.f, 0.f};
#pragma unroll
        for (int k = 0; k < 4; ++k) { const int yr = __shfl(yrow_l, k); const float wk = __shfl(wv, k); const v2u* yp = (const v2u*)(Y + (size_t)yr * D) + F.lane;
#pragma unroll
            for (int j = 0; j < 4; ++j) { const v2u w = yp[64 * j]; y[j].x += wk * bflo(w.x); y[j].y += wk * bfhi(w.x); y[j].z += wk * bflo(w.y); y[j].w += wk * bfhi(w.y); } }
        f32x4* xr = (f32x4*)(F.out + (size_t)r * D) + F.lane;
        f32x4 v[4]; float s = 0.f;
#pragma unroll
        for (int j = 0; j < 4; ++j) { const f32x4 g = *(const f32x4*)(mod + b * NMOD + MOD_GATE2 + 4 * F.lane + 256 * j); v[j] = xr[64 * j] * DN_ALPHA + g * y[j]; s += (v[j].x + v[j].y) + (v[j].z + v[j].w); }
        const float mean = wave_sum(s) * (1.f / D); float s2 = 0.f;
#pragma unroll
        for (int j = 0; j < 4; ++j) { v[j] = v[j] - mean; s2 += (v[j].x * v[j].x + v[j].y * v[j].y) + (v[j].z * v[j].z + v[j].w * v[j].w); }
        const float rstd = 1.f / sqrtf(wave_sum(s2) * (1.f / D) + LN_EPS);
#pragma unroll
        for (int j = 0; j < 4; ++j) { const f32x4 g = *(const f32x4*)(F.in[I_P2G] + 4 * F.lane + 256 * j), bb = *(const f32x4*)(F.in[I_P2B] + 4 * F.lane + 256 * j); xr[64 * j] = v[j] * rstd * g + bb; }
    }
}

struct Args { const float* in[30]; float* out; unsigned char* ws; int ph_lo, ph_hi; };
__global__ void __launch_bounds__(NWAVES * 64, 2) mk_fwd(Args args) {
    extern __shared__ __attribute__((aligned(16))) unsigned char lds[];
    Frame F;
    F.lds = (LAS unsigned char*)lds;
    F.MISC = (volatile LAS unsigned*)(F.lds + MISC_OFF);
    F.tid = threadIdx.x; F.lane = F.tid & 63; F.wave = __builtin_amdgcn_readfirstlane(F.tid >> 6);
    F.G = gridDim.x; { const int bx = blockIdx.x; F.vcu = (F.G % 8 == 0) ? (bx % 8) * (F.G / 8) + bx / 8 : bx; }
    F.ws = args.ws; F.ctl = (gu32*)(args.ws + WS_CTL); F.out = args.out;
#pragma unroll
    for (int i = 0; i < 30; ++i) F.in[i] = args.in[i];
    for (int u = F.tid; u < (LDS_BYTES - LDSCTL_OFF) / 4; u += NWAVES * 64) ((LAS unsigned*)(F.lds + LDSCTL_OFF))[u] = 0u;
    __syncthreads();
    XcdBarrier bar; bar.bar = (unsigned*)(F.ctl + CW_BAR); bar.x = 0; bar.st = nullptr;
    if (N_LAUNCHES == 1) bar = xcd_barrier_post((unsigned*)(F.ctl + CW_BAR), F.MISC + 8);
#define GRID_BAR() do { if (N_LAUNCHES == 1) xcd_barrier(bar); } while (0)
    const int lo = args.ph_lo, hi = args.ph_hi;
#ifndef PHASE_MASK
#define PHASE_MASK 0x7ff
#endif
#define IN(k) ((((PHASE_MASK) >> (k)) & 1) && lo <= (k) && (k) < hi)
#define BOTH(k) (IN(k) && IN((k) + 1))
    using namespace pg8;
    PG8_LAS unsigned char* ring = F.lds + RING_OFF;
    bf16* const W_IN = (bf16*)(F.ws + WS_WIN); bf16* const W_PA = (bf16*)(F.ws + WS_WPA); bf16* const W_PB = (bf16*)(F.ws + WS_WPB); bf16* const W_OUT = (bf16*)(F.ws + WS_WOUT);
    bf16* const W_UP = (bf16*)(F.ws + WS_WUP); bf16* const W_DN = (bf16*)(F.ws + WS_WDN);

    if (IN(0)) { p0_prologue(F); if (BOTH(0)) GRID_BAR(); }
    if (IN(1)) { p1_lnmod(F); if (BOTH(1)) GRID_BAR(); }
    if (IN(2)) {
        DenseOrder S; S.init((const bf16*)(F.ws + WS_H), W_IN, T, IN_DIM, D, F.G, (int)blockIdx.x);
        EpiG1 E{(bf16*)(F.ws + WS_Z), (bf16*)(F.ws + WS_GU), (size_t)(UB / 2), (const float*)(F.ws + WS_BINP)};
        gemm_phase<EpiG1, DenseOrder, PG8_ALIGN, PG8_SP2>(ring, D, S, E);
        if (BOTH(2)) GRID_BAR();
    }
    if (IN(3)) {
        for (int u = blockIdx.x; u < T / 128; u += F.G) {
#ifndef NO_CONV
            p3_conv_unit(F, u);
#endif
#ifndef NO_MIX
            p3_mix_unit(F, u);
#endif
        }
        if (BOTH(3)) GRID_BAR();
    }
    if (IN(4)) {
        { DenseOrder S; S.init((const bf16*)(F.ws + WS_AACT), W_PA, T, D, D, F.G, (int)blockIdx.x);
          EpiGate<0> E{(bf16*)(F.ws + WS_MERGED), (const bf16*)(F.ws + WS_SGA), F.in[I_BPA]};
          gemm_phase<EpiGate<0>, DenseOrder, PG8_ALIGN, PG8_SP2>(ring, D, S, E); }
        { DenseOrder S; S.init((const bf16*)(F.ws + WS_GATED), W_PB, T, D, D, F.G, (int)blockIdx.x);
          EpiGate<1> E{(bf16*)(F.ws + WS_MERGED), (const bf16*)(F.ws + WS_SGB), F.in[I_BPB]};
          gemm_phase<EpiGate<1>, DenseOrder, PG8_ALIGN, PG8_SP2>(ring, D, S, E); }
        if (BOTH(4)) GRID_BAR();
    }
    if (IN(5)) {
        DenseOrder S; S.init((const bf16*)(F.ws + WS_MERGED), W_OUT, T, D, D, F.G, (int)blockIdx.x);
        EpiRes E{F.in[I_X], F.out, F.in[I_BOUT], (const float*)(F.ws + WS_MOD) + MOD_GATE1, DN_ALPHA};
        gemm_phase<EpiRes, DenseOrder, PG8_ALIGN, PG8_SP2>(ring, D, S, E);
        if (BOTH(5)) GRID_BAR();
    }
    if (IN(6)) { p6_router(F); if (BOTH(6)) GRID_BAR(); }
    if (IN(7)) { moe_tables(F); p7_gather(F); if (BOTH(7)) GRID_BAR(); }
    if (IN(8)) {
        if (!IN(7)) moe_tables(F);
        GroupedOrder S{(const PG8_LAS int*)(F.lds + TBL_TPU), (const PG8_LAS int*)(F.lds + TBL_RS), (const PG8_LAS int*)(F.lds + TBL_CNT), 8, F.G, (int)blockIdx.x,
                       (const char*)(F.ws + WS_XG), (const char*)W_UP, (size_t)D * 2, (size_t)BM * D * 2, (size_t)2048 * D * 2};
        EpiSwiglu E{(bf16*)(F.ws + WS_ACT), (const float*)(F.ws + WS_BUPP)};
        gemm_phase<EpiSwiglu, GroupedOrder, PG8_ALIGN, PG8_SP2>(ring, D, S, E);
        if (BOTH(8)) GRID_BAR();
    }
    if (IN(9)) {
        if (!IN(7)) moe_tables(F);
        GroupedOrder S{(const PG8_LAS int*)(F.lds + TBL_TPD), (const PG8_LAS int*)(F.lds + TBL_RS), (const PG8_LAS int*)(F.lds + TBL_CNT), 4, F.G, (int)blockIdx.x,
                       (const char*)(F.ws + WS_ACT), (const char*)W_DN, (size_t)D * 2, (size_t)BM * D * 2, (size_t)D * D * 2};
        EpiDown E{(bf16*)(F.ws + WS_Y), F.in[I_BDN]};
        gemm_phase<EpiDown, GroupedOrder, PG8_ALIGN, PG8_SP2>(ring, D, S, E);
        if (BOTH(9)) GRID_BAR();
    }
    if (IN(10)) {
        if (!IN(7)) moe_tables(F);
        p10_combine(F);
    }
#undef IN
#undef BOTH
#undef GRID_BAR
}

extern "C" void kernel_launch(void* const* d_in, const int* in_sizes, int n_in, void* d_out, int out_size, void* d_ws, size_t ws_size, hipStream_t stream) {
    static int grid = 0;
    if (grid == 0) {
        if (n_in != 30 || in_sizes[0] != T * D || out_size != T * D || ws_size < WS_END) { fprintf(stderr, "kernel_launch: unexpected shapes (n_in %d, in0 %d, out %d, ws %zu); nothing launched\n", n_in, n_in > 0 ? in_sizes[0] : -1, out_size, ws_size); grid = -1; return; }
        int dev = 0, cus = 0, per_cu = 0;
        if (hipGetDevice(&dev) != hipSuccess || hipDeviceGetAttribute(&cus, hipDeviceAttributeMultiprocessorCount, dev) != hipSuccess) { fprintf(stderr, "kernel_launch: device query failed\n"); grid = -1; return; }
        if (hipFuncSetAttribute((const void*)mk_fwd, hipFuncAttributeMaxDynamicSharedMemorySize, LDS_BYTES) != hipSuccess) { fprintf(stderr, "kernel_launch: hipFuncSetAttribute failed\n"); grid = -1; return; }
        if (hipOccupancyMaxActiveBlocksPerMultiprocessor(&per_cu, (const void*)mk_fwd, NWAVES * 64, LDS_BYTES) != hipSuccess || per_cu < 1) { fprintf(stderr, "kernel_launch: occupancy query reports %d workgroups per CU\n", per_cu); per_cu = 1; }
        (void)hipGetLastError();
        grid = cus;
    }
    if (grid < 0) return;
    if (hipMemsetAsync((char*)d_ws + WS_CTL, 0, CTL_ZERO_BYTES, stream) != hipSuccess) { fprintf(stderr, "kernel_launch: hipMemsetAsync failed\n"); return; }
    Args a{};
    for (int i = 0; i < 30; ++i) a.in[i] = (const float*)d_in[i];
    a.out = (float*)d_out; a.ws = (unsigned char*)d_ws;
    if (N_LAUNCHES == 1) {
        a.ph_lo = 0; a.ph_hi = NPH;
        void* kargs[] = {&a};
        hipError_t le = hipLaunchCooperativeKernel((const void*)mk_fwd, dim3(grid), dim3(NWAVES * 64), kargs, LDS_BYTES, stream);
        if (le != hipSuccess) { (void)hipGetLastError(); fprintf(stderr, "kernel_launch: cooperative launch failed (%s), plain launch instead\n", hipGetErrorName(le)); hipLaunchKernelGGL(mk_fwd, dim3(grid), dim3(NWAVES * 64), LDS_BYTES, stream, a); }
    } else {
        for (int li = 0; li < NPH; ++li) { a.ph_lo = li; a.ph_hi = li + 1; hipLaunchKernelGGL(mk_fwd, dim3(grid), dim3(NWAVES * 64), LDS_BYTES, stream, a); }
    }
}
```

```cpp
#include <hip/hip_runtime.h>
#include <cstdio>
#include <cstdint>

#ifndef MK_N_LAUNCHES
#define MK_N_LAUNCHES 1
#endif
#ifndef HOST_REPEAT
#define HOST_REPEAT 0
#endif

namespace pg8 {
#define PG8_LAS __attribute__((address_space(3)))
typedef unsigned short bf16_t;
typedef short bf16x8 __attribute__((ext_vector_type(8)));
typedef float f32x4 __attribute__((ext_vector_type(4)));
typedef float f32x2 __attribute__((ext_vector_type(2)));
typedef unsigned u32x4 __attribute__((ext_vector_type(4)));
typedef unsigned u32x2 __attribute__((ext_vector_type(2)));
constexpr int BM = 256, BK = 64, HALF = 128, HTB = HALF * BK * 2  , STAGE_BYTES = 8 * HTB, NXCD = 8, WGM = 8;

__host__ __device__ __forceinline__ int lds_off(int R, int c) { return (R >> 3) * 1024 + (c >> 2) * 512 + (R & 7) * 64 + (((c & 3) ^ (((R >> 3) & 1) << 1)) * 16); }
__host__ __device__ __forceinline__ int perm32(int rho) { const int n = rho >> 4, i = rho & 15; return 8 * (i >> 2) + 4 * n + (i & 3); }

struct Unit { int pn; int row0; int e; int nvalid; int l0; };

struct DenseOrder {
    static constexpr bool GATHER = false;
    __device__ __forceinline__ PG8_LAS unsigned* gtab() const { return nullptr; }
    __device__ __forceinline__ unsigned rowoff(const Unit&, int) const { return 0u; }
    int nM, nN, nwg, G, c; const char* A; const char* Bt; size_t rowbytes, tstep;
    __device__ __forceinline__ void init(const void* A_, const void* Bt_, int M, int N, int rowbytes_, int G_, int c_) { nM = M / BM; nN = N / BM; nwg = nM * nN; G = G_; c = c_; A = (const char*)A_; Bt = (const char*)Bt_; rowbytes = (size_t)rowbytes_; tstep = (size_t)BM * rowbytes_; }
    __device__ __forceinline__ bool next(int i, Unit& u) const {
        const long L = (long)i * G + c; if (L >= nwg) return false;
        int wgid = (int)L; { const int q = nwg / NXCD, r = nwg % NXCD, xcd = wgid % NXCD, off = wgid / NXCD; wgid = (xcd < r ? xcd * (q + 1) : r * (q + 1) + (xcd - r) * q) + off; }
        const int nig = WGM * nN, gid = wgid / nig, fm = gid * WGM, gsz = (nM - fm) < WGM ? (nM - fm) : WGM;
        const int pm = fm + ((wgid % nig) % gsz); u.pn = (wgid % nig) / gsz; u.row0 = pm * BM; u.e = 0; u.nvalid = BM; u.l0 = 0; return true;
    }
    __device__ __forceinline__ const char* abase(const Unit& u) const { return A + (size_t)u.row0 * rowbytes; }
    __device__ __forceinline__ const char* bbase(const Unit& u) const { return Bt + (size_t)u.pn * tstep; }
    __device__ __forceinline__ void a_ready(const Unit&) const {}
    __device__ __forceinline__ void done(const Unit&) const {}
};
template <bool GATHER_> struct GroupedOrder {
    static constexpr bool GATHER = GATHER_; static constexpr int LSTRIDE = 32768;
    const PG8_LAS int* tp; const PG8_LAS int* rs; const PG8_LAS int* cnt; int npn, G, c; const char* A; const char* Bt; size_t rowbytes, tstep, estride; const int* list; PG8_LAS unsigned* gt;
    __device__ __forceinline__ bool next(int i, Unit& u) const {
        const int tot = __builtin_amdgcn_readfirstlane(tp[32]); const int x = c & (NXCD - 1), k = c >> 3, nx = (G - x + NXCD - 1) >> 3;
        const int chunk = (((tot / npn) + NXCD - 1) >> 3) * npn, j = i * nx + k, L = x * chunk + j; if (j >= chunk || L >= tot) return false;
        int e = 0;
        for (int j = 1; j < 32; ++j) e += (L >= __builtin_amdgcn_readfirstlane(tp[j])) ? 1 : 0;
        e = __builtin_amdgcn_readfirstlane(e);
        const int local = L - __builtin_amdgcn_readfirstlane(tp[e]); const int mt = local / npn; u.pn = __builtin_amdgcn_readfirstlane(local - mt * npn); u.e = e; u.l0 = __builtin_amdgcn_readfirstlane(e * LSTRIDE + BM * mt);
        u.row0 = __builtin_amdgcn_readfirstlane(__builtin_amdgcn_readfirstlane(rs[e]) + BM * mt); const int left = __builtin_amdgcn_readfirstlane(cnt[e]) - BM * mt; u.nvalid = __builtin_amdgcn_readfirstlane(left < BM ? left : BM); return true;
    }
    __device__ __forceinline__ const char* abase(const Unit& u) const { return GATHER ? A : A + (size_t)u.row0 * rowbytes; }
    __device__ __forceinline__ const char* bbase(const Unit& u) const { return Bt + (size_t)u.e * estride + (size_t)u.pn * tstep; }
    __device__ __forceinline__ PG8_LAS unsigned* gtab() const { return gt; }
    __device__ __forceinline__ unsigned rowoff(const Unit& u, int rowl) const { const int r = rowl < u.nvalid ? rowl : 0; return ((unsigned)list[u.l0 + r] & (unsigned)(LSTRIDE - 1)) * (unsigned)rowbytes; }
    __device__ __forceinline__ void a_ready(const Unit&) const {}
    __device__ __forceinline__ void done(const Unit&) const {}
};

__device__ __forceinline__ unsigned cvt_pk_bf16(float lo, float hi) { unsigned r; asm volatile("v_cvt_pk_bf16_f32 %0, %1, %2" : "=v"(r) : "v"(lo), "v"(hi)); return r; }
__device__ __forceinline__ unsigned pk4_fp8_raw(float a, float b, float c, float d) { int p = __builtin_amdgcn_cvt_pk_fp8_f32(a, b, 0, false); p = __builtin_amdgcn_cvt_pk_fp8_f32(c, d, p, true); return (unsigned)p; }
__device__ __forceinline__ float sat8(float v) { return __builtin_amdgcn_fmed3f(v, -448.0f, 448.0f); }
__device__ __forceinline__ unsigned pk4_fp8(float a, float b, float c, float d) { int p = __builtin_amdgcn_cvt_pk_fp8_f32(sat8(a), sat8(b), 0, false); p = __builtin_amdgcn_cvt_pk_fp8_f32(sat8(c), sat8(d), p, true); return (unsigned)p; }
constexpr float W8_SCALE = 32.0f, ACT8_SCALE = 4.0f, G8_SCALE = 128.0f, YO8_SCALE = 64.0f;
__device__ __forceinline__ float bf_lo(unsigned w) { return __uint_as_float(w << 16); }
__device__ __forceinline__ float bf_hi(unsigned w) { return __uint_as_float(w & 0xffff0000u); }
__device__ __forceinline__ f32x2 gelu_pk(f32x2 v) {
    const f32x2 av = __builtin_elementwise_abs(v), d = av * 0.2316418882f + 1.0f;
    f32x2 t; t.x = __builtin_amdgcn_rcpf(d.x); t.y = __builtin_amdgcn_rcpf(d.y);
    f32x2 q = t * 0.5307027145f + (-0.7265760135f); q = q * t + 0.7107068705f; q = q * t + (-0.142248368f); q = q * t + 0.127414796f; q = q * t;
    const f32x2 s = (v * v) * (-0.72134752044f);
    f32x2 e; e.x = __builtin_amdgcn_exp2f(s.x); e.y = __builtin_amdgcn_exp2f(s.y);
    const f32x2 m = v * (q * e), r = v - m;
    f32x2 o; o.x = v.x < 0.f ? m.x : r.x; o.y = v.y < 0.f ? m.y : r.y; return o;
}
__device__ __forceinline__ f32x4 gelu4(f32x4 v) { const f32x2 a = gelu_pk((f32x2){v[0], v[1]}), b = gelu_pk((f32x2){v[2], v[3]}); return (f32x4){a.x, a.y, b.x, b.y}; }
__device__ __forceinline__ float sigm(float x) { return __builtin_amdgcn_rcpf(1.0f + __builtin_amdgcn_exp2f(-1.44269504089f * x)); }
__device__ __forceinline__ f32x4 sigm4(f32x4 v) { const f32x4 t = v * (-1.44269504089f); const f32x4 d = (f32x4){__builtin_amdgcn_exp2f(t[0]), __builtin_amdgcn_exp2f(t[1]), __builtin_amdgcn_exp2f(t[2]), __builtin_amdgcn_exp2f(t[3])} + 1.0f;
    return (f32x4){__builtin_amdgcn_rcpf(d[0]), __builtin_amdgcn_rcpf(d[1]), __builtin_amdgcn_rcpf(d[2]), __builtin_amdgcn_rcpf(d[3])}; }
__device__ __forceinline__ u32x4 pack8(f32x4 v0, f32x4 v1) { u32x4 w; w.x = cvt_pk_bf16(v0[0], v0[1]); w.y = cvt_pk_bf16(v0[2], v0[3]); w.z = cvt_pk_bf16(v1[0], v1[1]); w.w = cvt_pk_bf16(v1[2], v1[3]); return w; }
__device__ __forceinline__ void unpack8(u32x4 w, f32x4& v0, f32x4& v1) { v0 = (f32x4){bf_lo(w.x), bf_hi(w.x), bf_lo(w.y), bf_hi(w.y)}; v1 = (f32x4){bf_lo(w.z), bf_hi(w.z), bf_lo(w.w), bf_hi(w.w)}; }

constexpr int LDC = 1024;

template <int ROWB, int NP> struct Stage {
    static constexpr int PITCH = ROWB + 16;
    PG8_LAS unsigned char* base;
    __device__ __forceinline__ void put16(int p, int rho, int bytecol, u32x4 v) const { *(PG8_LAS u32x4*)(base + (p * 32 + rho) * PITCH + bytecol) = v; }
    __device__ __forceinline__ void put8(int p, int rho, int bytecol, u32x2 v) const { *(PG8_LAS u32x2*)(base + (p * 32 + rho) * PITCH + bytecol) = v; }
    __device__ __forceinline__ void flush(int tid, unsigned char* dst, size_t pitch, int ai, int m0, int nvalid) const {
        asm volatile("s_waitcnt lgkmcnt(0)" ::: "memory"); __builtin_amdgcn_s_barrier(); asm volatile("" ::: "memory");
        constexpr int CPR = ROWB / 16, NCH = 32 * NP * CPR; static_assert(NCH == 1024, "two 16-byte chunks per thread");
#pragma unroll
        for (int i = 0; i < 2; ++i) { const int q = tid + 512 * i, sg = q / CPR, c = q % CPR, p = sg >> 5, rho = sg & 31, trow = 128 * ai + 64 * (rho >> 4) + 16 * (m0 + p) + (rho & 15);
            const u32x4 v = *(const PG8_LAS u32x4*)(base + sg * PITCH + 16 * c);
            if (trow < nvalid) __builtin_nontemporal_store(v, (u32x4*)(dst + (size_t)trow * pitch + 16 * c)); }
        asm volatile("s_waitcnt lgkmcnt(0)" ::: "memory"); __builtin_amdgcn_s_barrier(); asm volatile("" ::: "memory");
    }
};

struct EpiG1 {
    static constexpr bool PERM = true, AFTER_DRAIN = false;
    static constexpr int NVEC = 1;
    bf16_t *Z, *GU; size_t tstride; const float* bias; PG8_LAS unsigned char* evl;
    __device__ __forceinline__ const float* evec(const Unit& u, int) const { return bias + u.pn * BM; }
    __device__ __forceinline__ void operator()(const f32x4 (&acc)[2][2][4][2], const Unit& u, int wr, int wc, int fr, int fq, int tid, const PG8_LAS float* ev) const {
        const int row0 = u.row0 + wr * 64 + fr;
        f32x4 bv[2][2];
#pragma unroll
        for (int bj = 0; bj < 2; ++bj)
#pragma unroll
            for (int n = 0; n < 2; ++n) bv[bj][n] = *(const PG8_LAS f32x4*)(ev + wc * 32 + 8 * fq + bj * HALF + 4 * n);
        if (u.pn < 8) {
            const int col0 = u.pn * HALF + wc * 32 + 8 * fq;
#pragma unroll
            for (int ai = 0; ai < 2; ++ai)
#pragma unroll
                for (int m = 0; m < 4; ++m) { bf16_t* rowp = Z + (size_t)(row0 + ai * HALF + m * 16) * LDC + col0;
                    const f32x4 v0 = acc[ai][0][m][0] * (1.0f / W8_SCALE) + bv[0][0], v1 = acc[ai][0][m][1] * (1.0f / W8_SCALE) + bv[0][1], g0 = acc[ai][1][m][0] * (1.0f / W8_SCALE) + bv[1][0], g1 = acc[ai][1][m][1] * (1.0f / W8_SCALE) + bv[1][1];
                    *(u32x4*)rowp = pack8(v0 * sigm4(g0), v1 * sigm4(g1)); }
        } else {
            const int t = (u.pn - 8) >> 2; bf16_t* base = GU + (size_t)t * tstride;
            const int col0 = ((u.pn - 8) & 3) * BM + wc * 32 + 8 * fq;
#pragma unroll
            for (int ai = 0; ai < 2; ++ai)
#pragma unroll
                for (int m = 0; m < 4; ++m) { bf16_t* rowp = base + (size_t)(row0 + ai * HALF + m * 16) * LDC + col0;
#pragma unroll
                    for (int bj = 0; bj < 2; ++bj) { f32x4 v0 = acc[ai][bj][m][0] * (1.0f / W8_SCALE) + bv[bj][0], v1 = acc[ai][bj][m][1] * (1.0f / W8_SCALE) + bv[bj][1];
                        if (t < 2) { v0 = gelu4(v0); v1 = gelu4(v1); *(u32x4*)(rowp + bj * HALF) = pack8(v0, v1); }
                        else { v0 = sigm4(v0) * G8_SCALE; v1 = sigm4(v1) * G8_SCALE; u32x2 w; w.x = pk4_fp8_raw(v0[0], v0[1], v0[2], v0[3]); w.y = pk4_fp8_raw(v1[0], v1[1], v1[2], v1[3]);
                            *(u32x2*)((unsigned char*)base + (size_t)(row0 + ai * HALF + m * 16) * LDC + col0 + bj * HALF) = w; } } }
        }
    }
};
template <int MODE> struct EpiGate {
    static constexpr bool PERM = true, AFTER_DRAIN = false;
    static constexpr int NVEC = 0;
    bf16_t* M1; unsigned char* MG8; const unsigned char* Gt; const float* bias; PG8_LAS unsigned char* evl;
    __device__ __forceinline__ const float* evec(const Unit&, int) const { return nullptr; }
    __device__ __forceinline__ void operator()(const f32x4 (&acc)[2][2][4][2], const Unit& u, int wr, int wc, int fr, int fq, int tid, const PG8_LAS float* ev) const {
        const int row0 = u.row0 + wr * 64 + fr, col0 = u.pn * BM + wc * 32 + 8 * fq;
        f32x4 bv[2][2];
#pragma unroll
        for (int bj = 0; bj < 2; ++bj)
#pragma unroll
            for (int n = 0; n < 2; ++n) bv[bj][n] = *(const f32x4*)(bias + col0 + bj * HALF + 4 * n);
#pragma unroll
        for (int ai = 0; ai < 2; ++ai) {
            u32x2 gq[4][2]; u32x4 oq[4][2];
#pragma unroll
            for (int m = 0; m < 4; ++m)
#pragma unroll
                for (int bj = 0; bj < 2; ++bj) { const size_t off = (size_t)(row0 + ai * HALF + m * 16) * LDC + col0 + bj * HALF; gq[m][bj] = *(const u32x2*)(Gt + off); if (MODE == 1) oq[m][bj] = *(const u32x4*)(M1 + off); }
            asm volatile("" ::: "memory");
#pragma unroll
            for (int m = 0; m < 4; ++m)
#pragma unroll
                for (int bj = 0; bj < 2; ++bj) { const size_t off = (size_t)(row0 + ai * HALF + m * 16) * LDC + col0 + bj * HALF; const f32x2 ga = __builtin_amdgcn_cvt_pk_f32_fp8((int)gq[m][bj].x, false), gb = __builtin_amdgcn_cvt_pk_f32_fp8((int)gq[m][bj].x, true), gc = __builtin_amdgcn_cvt_pk_f32_fp8((int)gq[m][bj].y, false), gd = __builtin_amdgcn_cvt_pk_f32_fp8((int)gq[m][bj].y, true);
                    const f32x4 g0 = {ga.x, ga.y, gb.x, gb.y}, g1 = {gc.x, gc.y, gd.x, gd.y};
                    f32x4 v0 = (acc[ai][bj][m][0] * (1.0f / (W8_SCALE * G8_SCALE)) + bv[bj][0] * (1.0f / G8_SCALE)) * g0, v1 = (acc[ai][bj][m][1] * (1.0f / (W8_SCALE * G8_SCALE)) + bv[bj][1] * (1.0f / G8_SCALE)) * g1;
                    if (MODE == 1) { f32x4 o0, o1; unpack8(oq[m][bj], o0, o1); v0 += o0; v1 += o1;
                        u32x2 w; w.x = pk4_fp8(v0[0], v0[1], v0[2], v0[3]); w.y = pk4_fp8(v1[0], v1[1], v1[2], v1[3]); *(u32x2*)(MG8 + off) = w; }
                    else *(u32x4*)(M1 + off) = pack8(v0, v1); }
        }
    }
};
struct EpiYO {
    static constexpr bool PERM = true, AFTER_DRAIN = false;
    static constexpr int NVEC = 2;
    unsigned char* YO; const float* bias; const float* gate; PG8_LAS unsigned char* evl;
    __device__ __forceinline__ const float* evec(const Unit& u, int v) const { return v == 0 ? bias + u.pn * BM : gate + (size_t)(u.row0 >> 12) * 6144 + u.pn * BM; }
    __device__ __forceinline__ void operator()(const f32x4 (&acc)[2][2][4][2], const Unit& u, int wr, int wc, int fr, int fq, int tid, const PG8_LAS float* ev) const {
        const int row0 = u.row0 + wr * 64 + fr, col0 = u.pn * BM + wc * 32 + 8 * fq;
        f32x4 bv[2][2], gv[2][2];
#pragma unroll
        for (int bj = 0; bj < 2; ++bj)
#pragma unroll
            for (int n = 0; n < 2; ++n) { bv[bj][n] = *(const PG8_LAS f32x4*)(ev + wc * 32 + 8 * fq + bj * HALF + 4 * n); gv[bj][n] = *(const PG8_LAS f32x4*)(ev + 256 + wc * 32 + 8 * fq + bj * HALF + 4 * n); }
#pragma unroll
        for (int ai = 0; ai < 2; ++ai)
#pragma unroll
            for (int m = 0; m < 4; ++m) { unsigned char* rowp = YO + (size_t)(row0 + ai * HALF + m * 16) * LDC + col0;
#pragma unroll
                for (int bj = 0; bj < 2; ++bj) { const f32x4 v0 = gv[bj][0] * (acc[ai][bj][m][0] * (YO8_SCALE / W8_SCALE) + bv[bj][0] * YO8_SCALE), v1 = gv[bj][1] * (acc[ai][bj][m][1] * (YO8_SCALE / W8_SCALE) + bv[bj][1] * YO8_SCALE);
                    u32x2 w; w.x = pk4_fp8(v0[0], v0[1], v0[2], v0[3]); w.y = pk4_fp8(v1[0], v1[1], v1[2], v1[3]); *(u32x2*)(rowp + bj * HALF) = w; } }
    }
};
struct EpiSwiglu {
    static constexpr bool PERM = true, AFTER_DRAIN = false;
    static constexpr int NVEC = 1;
    unsigned char* ACT; const float* bias; PG8_LAS unsigned char* evl;
    __device__ __forceinline__ const float* evec(const Unit& u, int) const { return bias + (size_t)u.e * 2048 + u.pn * BM; }
    __device__ __forceinline__ void operator()(const f32x4 (&acc)[2][2][4][2], const Unit& u, int wr, int wc, int fr, int fq, int tid, const PG8_LAS float* ev) const {
        const int rl0 = wr * 64 + fr, col0 = u.pn * HALF + wc * 32 + 8 * fq;
        f32x4 bv[2][2];
#pragma unroll
        for (int bj = 0; bj < 2; ++bj)
#pragma unroll
            for (int n = 0; n < 2; ++n) bv[bj][n] = *(const PG8_LAS f32x4*)(ev + wc * 32 + 8 * fq + bj * HALF + 4 * n);
#pragma unroll
        for (int ai = 0; ai < 2; ++ai)
#pragma unroll
            for (int m = 0; m < 4; ++m) { const int rl = rl0 + ai * HALF + m * 16;
                f32x4 o[2];
#pragma unroll
                for (int n = 0; n < 2; ++n) {
                    const f32x4 gl = acc[ai][0][m][n] * (1.0f / W8_SCALE) + bv[0][n], li = acc[ai][1][m][n] * (1.0f / W8_SCALE) + bv[1][n];
                    const f32x4 g = __builtin_elementwise_min(gl, (f32x4){7.0f, 7.0f, 7.0f, 7.0f});
                    const f32x4 l4 = (f32x4){__builtin_amdgcn_fmed3f(li[0], -7.0f, 7.0f), __builtin_amdgcn_fmed3f(li[1], -7.0f, 7.0f), __builtin_amdgcn_fmed3f(li[2], -7.0f, 7.0f), __builtin_amdgcn_fmed3f(li[3], -7.0f, 7.0f)} * ACT8_SCALE + ACT8_SCALE;
                    const f32x4 t = g * (-1.702f * 1.44269504089f);
                    const f32x4 d = (f32x4){__builtin_amdgcn_exp2f(t[0]), __builtin_amdgcn_exp2f(t[1]), __builtin_amdgcn_exp2f(t[2]), __builtin_amdgcn_exp2f(t[3])} + 1.0f;
                    const f32x4 r = {__builtin_amdgcn_rcpf(d[0]), __builtin_amdgcn_rcpf(d[1]), __builtin_amdgcn_rcpf(d[2]), __builtin_amdgcn_rcpf(d[3])};
                    o[n] = (g * r) * l4; }
                if (rl < u.nvalid) { u32x2 w; w.x = pk4_fp8_raw(o[0][0], o[0][1], o[0][2], o[0][3]); w.y = pk4_fp8_raw(o[1][0], o[1][1], o[1][2], o[1][3]); *(u32x2*)(ACT + (size_t)(u.row0 + rl) * LDC + col0) = w; } }
    }
};
constexpr float Y8_SCALE = 16.0f;
struct EpiDown {
    static constexpr bool PERM = true, AFTER_DRAIN = false;
    static constexpr int NVEC = 1;
    unsigned char* Y8; const float* bias; PG8_LAS unsigned char* stg; PG8_LAS unsigned char* evl;
    __device__ __forceinline__ const float* evec(const Unit& u, int) const { return bias + (size_t)u.e * 1024 + u.pn * BM; }
    __device__ __forceinline__ void operator()(const f32x4 (&acc)[2][2][4][2], const Unit& u, int wr, int wc, int fr, int fq, int tid, const PG8_LAS float* ev) const {
        f32x4 bv[2][2];
#pragma unroll
        for (int bj = 0; bj < 2; ++bj)
#pragma unroll
            for (int n = 0; n < 2; ++n) bv[bj][n] = *(const PG8_LAS f32x4*)(ev + wc * 32 + 8 * fq + bj * HALF + 4 * n) * Y8_SCALE;
        const Stage<256, 2> st{stg}; unsigned char* dst = Y8 + (size_t)u.row0 * LDC + u.pn * BM;
#pragma unroll
        for (int ai = 0; ai < 2; ++ai)
#pragma unroll
            for (int m = 0; m < 4; ++m) {
#pragma unroll
                for (int bj = 0; bj < 2; ++bj) { const f32x4 v0 = acc[ai][bj][m][0] * (Y8_SCALE / (W8_SCALE * ACT8_SCALE)) + bv[bj][0], v1 = acc[ai][bj][m][1] * (Y8_SCALE / (W8_SCALE * ACT8_SCALE)) + bv[bj][1];
                    u32x2 w; w.x = pk4_fp8(v0[0], v0[1], v0[2], v0[3]); w.y = pk4_fp8(v1[0], v1[1], v1[2], v1[3]); st.put8(m & 1, 16 * wr + fr, bj * HALF + wc * 32 + 8 * fq, w); }
                if (m & 1) st.flush(tid, dst, LDC, ai, m - 1, u.nvalid); }
    }
};

typedef int v8i __attribute__((ext_vector_type(8)));
typedef int v4i __attribute__((ext_vector_type(4)));
template <class Epi, class Sched, bool ALIGN_EPI = false, bool F8 = false>
__device__ __forceinline__ void gemm_phase(PG8_LAS unsigned char* lds, const int rowbytes, const Sched& S, const Epi& E, const int tid) {
    constexpr bool GA = Sched::GATHER;
    int lane_ = tid & 63; asm volatile("" : "+v"(lane_));
    const int wid = __builtin_amdgcn_readfirstlane(tid >> 6), lane = lane_, wr = wid >> 2, wc = wid & 3, fr = lane & 15, fq = lane >> 4;
    const int nt = rowbytes / 128;
    unsigned voffA, voffB;
    { const int R = wid * 8 + ((lane >> 2) & 7), cb = (((lane >> 5) << 2) | ((lane & 3) ^ ((wid & 1) << 1))) * 16; const int Rb = Epi::PERM ? ((R & ~31) + perm32(R & 31)) : R; voffA = GA ? (unsigned)cb : (unsigned)(R * rowbytes + cb); voffB = (unsigned)(Rb * rowbytes + cb); }
    const size_t qstep = (size_t)64 * rowbytes;
    const size_t kstep = (size_t)(BK * 2);
    const size_t hstep = (size_t)HALF * rowbytes;
    const unsigned ldsw = (unsigned)wid * 1024u, ldsbase = (unsigned)(unsigned long)lds;
    const int aoff = lds_off(wr * 64 + fr, fq); int boff = lds_off(wc * 32 + fr, fq) + 4 * HTB;
    asm volatile("" : "+v"(boff));
#define PG8_SA(b, h) (((b) * 2 + (h)) * HTB)
#define PG8_SB(b, h) ((4 + (b) * 2 + (h)) * HTB)
#define PG8_DMA(gb, lo, vo) do { unsigned keep_; asm volatile("s_mov_b32 %0, m0\n\ts_mov_b32 m0, %3\n\ts_nop 0\n\tglobal_load_lds_dwordx4 %1, %2\n\ts_mov_b32 m0, %0" : "=&s"(keep_) : "v"(vo), "s"(gb), "s"(lo) : "memory"); } while (0)
#define PG8_STAGE(bufoff, gbase, voff) do { const char* gb0_ = (const char*)(gbase); const char* gb1_ = gb0_ + qstep; const unsigned l0_ = ldsbase + (unsigned)(bufoff) + ldsw; \
        PG8_DMA(gb0_, l0_, voff); PG8_DMA(gb1_, l0_ + 8192u, voff); } while (0)
#define PG8_STAGE_A(bufoff, ap, h, slot) do { if constexpr (GA) { unsigned l_ = __builtin_amdgcn_mbcnt_hi(~0u, __builtin_amdgcn_mbcnt_lo(~0u, 0u)); asm volatile("" : "+v"(l_));     \
            const unsigned cb_ = (((l_ >> 5) << 2) | ((l_ & 3u) ^ ((unsigned)(wid & 1) << 1))) * 16u; PG8_LAS unsigned* gt_ = S.gtab() + wid * 256 + (slot) * 64 + ((l_ >> 2) & 7u) + 16 * (h); const unsigned g0_ = gt_[0] + cb_, g1_ = gt_[8] + cb_; \
            const char* gb_ = (const char*)(ap); const unsigned l0_ = ldsbase + (unsigned)(bufoff) + ldsw; PG8_DMA(gb_, l0_, g0_); PG8_DMA(gb_, l0_ + 8192u, g1_); } \
        else { PG8_STAGE(bufoff, (ap) + (h) * hstep, voffA); } } while (0)
#define PG8_GFILL(u, slot) do { if constexpr (GA) { int l_ = (int)__builtin_amdgcn_mbcnt_hi(~0u, __builtin_amdgcn_mbcnt_lo(~0u, 0u)); asm volatile("" : "+v"(l_));     \
        (S.gtab() + wid * 256)[(slot) * 64 + (l_ & 31)] = S.rowoff(u, wid * 8 + (l_ & 7) + 64 * ((l_ >> 3) & 3)); } } while (0)
#define PG8_LD16(off) (*(const PG8_LAS v4i*)(lds + (off)))
#define PG8_LDA(dst, b, h) do { _Pragma("unroll") for (int m = 0; m < 4; ++m) { const v4i lo_ = PG8_LD16(PG8_SA(b, h) + aoff + m * 2048), hi_ = PG8_LD16(PG8_SA(b, h) + aoff + m * 2048 + 512); dst[m] = __builtin_shufflevector(lo_, hi_, 0, 1, 2, 3, 4, 5, 6, 7); } } while (0)
#define PG8_LDB(dst, b, h) do { _Pragma("unroll") for (int n = 0; n < 2; ++n) { const v4i lo_ = PG8_LD16(PG8_SA(b, h) + boff + n * 2048), hi_ = PG8_LD16(PG8_SA(b, h) + boff + n * 2048 + 512); dst[n] = __builtin_shufflevector(lo_, hi_, 0, 1, 2, 3, 4, 5, 6, 7); } } while (0)
#define PG8_MMA(ai, bj, At, Bt, ZC) do { __builtin_amdgcn_s_setprio(1); _Pragma("unroll") for (int m = 0; m < 4; ++m) _Pragma("unroll") for (int n = 0; n < 2; ++n) { \
        const f32x4 c0_ = (ZC) ? (f32x4){0.f, 0.f, 0.f, 0.f} : acc[ai][bj][m][n];     \
        if constexpr (F8) acc[ai][bj][m][n] = __builtin_amdgcn_mfma_scale_f32_16x16x128_f8f6f4(Bt[n], At[m], c0_, 0, 0, 0, 0, 0, 0); \
        else { acc[ai][bj][m][n] = __builtin_amdgcn_mfma_f32_16x16x32_bf16((bf16x8)__builtin_shufflevector(Bt[n], Bt[n], 0, 1, 2, 3), (bf16x8)__builtin_shufflevector(At[m], At[m], 0, 1, 2, 3), c0_, 0, 0, 0); \
               acc[ai][bj][m][n] = __builtin_amdgcn_mfma_f32_16x16x32_bf16((bf16x8)__builtin_shufflevector(Bt[n], Bt[n], 4, 5, 6, 7), (bf16x8)__builtin_shufflevector(At[m], At[m], 4, 5, 6, 7), acc[ai][bj][m][n], 0, 0, 0); } } \
        __builtin_amdgcn_s_setprio(0); } while (0)
#define PG8_WAIT_V(n) asm volatile("s_waitcnt vmcnt(" #n ")" ::: "memory")
#define PG8_WAIT_L(n) asm volatile("s_waitcnt lgkmcnt(" #n ")" ::: "memory")
#define PG8_BAR __builtin_amdgcn_s_barrier()
#define PG8_SCHED __builtin_amdgcn_sched_barrier(0)
    Unit cur, nxt; int ui = 0;
    if (!S.next(0, cur)) return;
    if constexpr (GA) { PG8_GFILL(cur, 0); Unit u1; if (S.next(1, u1)) PG8_GFILL(u1, 1); }
    f32x4 acc[2][2][4][2];
    v8i At[4], B0[2], B1[2];
    const char* cA = S.abase(cur); const char* cB = S.bbase(cur);
    S.a_ready(cur);
#define PG8_EVEC(u_, slot_) do { if (wid == 0) { _Pragma("unroll") for (int v_ = 0; v_ < Epi::NVEC; ++v_) { const char* gb_ = (const char*)E.evec(u_, v_); const unsigned lo_ = evbase + (unsigned)((slot_) * Epi::NVEC + v_) * 1024u; unsigned vo_ = __builtin_amdgcn_mbcnt_hi(~0u, __builtin_amdgcn_mbcnt_lo(~0u, 0u)) * 16u; PG8_DMA(gb_, lo_, vo_); } } } while (0)
    const unsigned evbase = (unsigned)(unsigned long)E.evl;
    PG8_EVEC(cur, 0);
    PG8_STAGE(PG8_SB(0, 0), cB, voffB); PG8_STAGE(PG8_SB(0, 1), cB + hstep, voffB); PG8_STAGE_A(PG8_SA(0, 0), cA, 0, 0); PG8_STAGE_A(PG8_SA(0, 1), cA, 1, 0);
    if (wr == 1) PG8_BAR;
    PG8_WAIT_V(2); PG8_BAR;
    PG8_STAGE(PG8_SB(1, 0), cB + kstep, voffB); PG8_STAGE_A(PG8_SA(1, 0), cA + kstep, 0, 0); PG8_STAGE(PG8_SB(1, 1), cB + hstep + kstep, voffB);
    PG8_WAIT_V(6); PG8_BAR;
    for (;;) {
        const bool has_next = S.next(ui + 1, nxt);
        const char* nA = has_next ? S.abase(nxt) : cA; const char* nB = has_next ? S.bbase(nxt) : cB;
        const int sc = ui & 3, sn = has_next ? ((ui + 1) & 3) : sc;
#define PG8_KITER(t, ZC) do { \
            const bool last = ((t) == nt - 2); \
            const char* a1 = cA + (size_t)((t) + 1) * kstep; \
            const char* a2 = last ? nA : cA + (size_t)((t) + 2) * kstep; const char* b2 = last ? nB : cB + (size_t)((t) + 2) * kstep; \
            const char* a3 = a2 + kstep; const char* b3 = b2 + kstep; \
            const int s2 = last ? sn : sc; \
            if (last && has_next) S.a_ready(nxt); \
              \
            PG8_LDB(B0, 0, 0); PG8_LDB(B1, 0, 1); PG8_SCHED; PG8_LDA(At, 0, 0); PG8_STAGE_A(PG8_SA(1, 1), a1, 1, sc); \
            PG8_WAIT_V(8); PG8_WAIT_L(0); PG8_BAR; PG8_MMA(0, 0, At, B0, ZC); PG8_MMA(0, 1, At, B1, ZC); PG8_BAR; PG8_SCHED; \
              \
            PG8_LDA(At, 0, 1); PG8_STAGE(PG8_SB(0, 0), b2, voffB); PG8_STAGE(PG8_SB(0, 1), b2 + hstep, voffB); PG8_STAGE_A(PG8_SA(0, 0), a2, 0, s2); \
            PG8_WAIT_V(8); PG8_WAIT_L(0); PG8_BAR; PG8_MMA(1, 0, At, B0, ZC); PG8_MMA(1, 1, At, B1, ZC); PG8_BAR; PG8_SCHED; \
              \
            PG8_LDB(B0, 1, 0); PG8_LDB(B1, 1, 1); PG8_SCHED; PG8_LDA(At, 1, 0); PG8_STAGE_A(PG8_SA(0, 1), a2, 1, s2); \
            PG8_WAIT_V(8); PG8_WAIT_L(0); PG8_BAR; PG8_MMA(0, 0, At, B0, false); PG8_MMA(0, 1, At, B1, false); PG8_BAR; PG8_SCHED; \
              \
            PG8_LDA(At, 1, 1); PG8_STAGE(PG8_SB(1, 0), b3, voffB); PG8_STAGE(PG8_SB(1, 1), b3 + hstep, voffB); PG8_STAGE_A(PG8_SA(1, 0), a3, 0, s2); \
            PG8_WAIT_V(8); PG8_WAIT_L(0); PG8_BAR; PG8_MMA(1, 0, At, B0, false); PG8_MMA(1, 1, At, B1, false); PG8_BAR; PG8_SCHED; } while (0)
        PG8_KITER(0, true);
#pragma unroll 1
        for (int t = 2; t < nt; t += 2) PG8_KITER(t, false);
        if constexpr (ALIGN_EPI) { if (wr == 0) PG8_BAR; }
        { int l_ = (int)__builtin_amdgcn_mbcnt_hi(~0u, __builtin_amdgcn_mbcnt_lo(~0u, 0u)); asm volatile("" : "+v"(l_));
          E(acc, cur, wr, wc, l_ & 15, l_ >> 4, wid * 64 + l_, (const PG8_LAS float*)(E.evl + (ui & 1) * Epi::NVEC * 1024)); } S.done(cur);
        if (!has_next) break;
        if constexpr (GA) { Unit u2; if (S.next(ui + 2, u2)) PG8_GFILL(u2, (ui + 2) & 3); }
        cur = nxt; cA = nA; cB = nB; ++ui;
        PG8_EVEC(cur, ui & 1);
        if constexpr (ALIGN_EPI) { if (wr == 1) PG8_BAR; }
    }
    PG8_WAIT_V(0);
    if constexpr (!ALIGN_EPI) { if (wr == 0) PG8_BAR; }
    PG8_BAR;
#undef PG8_SA
#undef PG8_SB
#undef PG8_KITER
#undef PG8_EVEC
#undef PG8_DMA
#undef PG8_STAGE
#undef PG8_STAGE_A
#undef PG8_GFILL
#undef PG8_LD16
#undef PG8_LDA
#undef PG8_LDB
#undef PG8_MMA
#undef PG8_WAIT_V
#undef PG8_WAIT_L
#undef PG8_BAR
#undef PG8_SCHED
}
}

#ifndef PG8_SP2
#define PG8_SP2 true
#endif
#ifndef PG8_ALIGN
#define PG8_ALIGN true
#endif

constexpr int NWAVES = 8;
constexpr int NPH = 10;
constexpr int N_LAUNCHES = MK_N_LAUNCHES;
constexpr int T = 32768, D = 1024, NBATCH = 8, SEQ = 4096, IN_DIM = 6144, NE = 32, TOPK = 4, NMOD = 6144;
constexpr int NASSIGN = T * TOPK;
constexpr float LN_EPS = 1e-5f;
constexpr float DN_ALPHA = 1.189207115002721f;
constexpr int MOD_SHIFT1 = 0, MOD_SCALE1 = 1024, MOD_GATE1 = 2048, MOD_SHIFT2 = 3072, MOD_SCALE2 = 4096, MOD_GATE2 = 5120;

constexpr size_t MiB = 1u << 20;
constexpr size_t WS_CTL = 0, CTL_ZERO_BYTES = 1 * MiB;
constexpr size_t WS_MOD = 1 * MiB;
constexpr size_t WS_BINP = 1 * MiB + 256 * 1024;
constexpr size_t WS_BUPP = 1 * MiB + 320 * 1024;
constexpr size_t WS_WRT = 1 * MiB + 640 * 1024;
constexpr size_t WS_WSM = 1 * MiB + 768 * 1024;
constexpr size_t WS_TOK = 2 * MiB;
constexpr size_t WS_TOKE = 2 * MiB;
constexpr size_t WS_TOKW = 2 * MiB + 512 * 1024;
constexpr size_t WS_TOKR = 3 * MiB;
constexpr size_t WS_LIST = 4 * MiB;
constexpr size_t WS_WIN = 8 * MiB, WS_WPA = 20 * MiB, WS_WPB = 22 * MiB, WS_WOUT = 24 * MiB, WS_WUP = 26 * MiB, WS_WDN = 154 * MiB;
constexpr size_t UB = 64 * MiB;
constexpr size_t WS_R0 = 218 * MiB;
constexpr size_t WS_Z = WS_R0, WS_GU = WS_R0 + UB, WS_GV = WS_R0 + 2 * UB, WS_SGA = WS_R0 + 3 * UB, WS_SGB = WS_R0 + 4 * UB, WS_ACT = WS_R0;
constexpr size_t WS_R1 = 538 * MiB;
constexpr size_t WS_H = WS_R1, WS_AACT = WS_R1 + UB, WS_GATED = WS_R1 + 2 * UB, WS_MERGED = WS_R1 + 3 * UB, WS_XG = WS_R1, WS_Y = WS_R1, WS_M1 = WS_R1  , WS_YO = WS_R1 + 2 * UB;
constexpr size_t WS_X1 = WS_R0 + 2 * UB;
constexpr size_t WS_H2 = 795 * MiB;
constexpr size_t WS_END = 859 * MiB;
static_assert(WS_R0 + 5 * UB <= WS_R1 && WS_R1 + 4 * UB + MiB <= WS_H2 && WS_H2 + UB <= WS_END && WS_WDN + UB <= WS_R0 && WS_WUP + 2 * UB <= WS_WDN, "d_ws map");
static_assert((size_t)(NASSIGN + 256) * 2048 <= 4 * UB + MiB, "ACT / XG with 256 rows of slack");
constexpr int CW_BAR = 4096;
constexpr int CW_ECNT = 16384;

constexpr int RING_OFF = 0, RING_BYTES = 131072;
constexpr int LDSCTL_OFF = RING_BYTES, MISC_OFF = LDSCTL_OFF + 320;
constexpr int TBL_CNT = LDSCTL_OFF + 512, TBL_RS = LDSCTL_OFF + 640, TBL_TPU = LDSCTL_OFF + 784, TBL_TPD = LDSCTL_OFF + 928;
constexpr int RT_CNT = LDSCTL_OFF + 2048, RT_BASE = RT_CNT + 128, RT_RECE = RT_CNT + 256, RT_RECL = RT_RECE + 2048, RT_RECW = RT_RECL + 2048;
constexpr int PV6_OFF = LDSCTL_OFF + 8704;
constexpr int STG_OFF = LDSCTL_OFF + 1536;
constexpr int GTAB_OFF = LDSCTL_OFF + 19968;
constexpr int EVEC_OFF = LDSCTL_OFF + 28160;
constexpr int LDS_BYTES = 131072 + 28160 + 4096;
static_assert(STG_OFF + 18432 <= GTAB_OFF && GTAB_OFF + 8192 <= EVEC_OFF && LDS_BYTES <= 163840 && TBL_TPD + 144 <= STG_OFF, "LDS map");

#define GAS __attribute__((address_space(1)))
#define LAS __attribute__((address_space(3)))
typedef unsigned short bf16;
typedef unsigned v4u __attribute__((ext_vector_type(4)));
typedef unsigned v2u __attribute__((ext_vector_type(2)));
typedef float f32x4 __attribute__((ext_vector_type(4)));
typedef float f32x2 __attribute__((ext_vector_type(2)));
typedef short bf16x8 __attribute__((ext_vector_type(8)));
typedef GAS unsigned gu32;
#define RLX_AGENT __ATOMIC_RELAXED, __HIP_MEMORY_SCOPE_AGENT
#define LDS_WAIT() asm volatile("s_waitcnt lgkmcnt(0)" ::: "memory")
#define VM_WAIT() asm volatile("s_waitcnt vmcnt(0)" ::: "memory")
__device__ __forceinline__ unsigned f2bf(float f) { unsigned u = __builtin_bit_cast(unsigned, f); return (u + 0x7fffu + ((u >> 16) & 1u)) >> 16; }
__device__ __forceinline__ unsigned pk2(float lo, float hi) { return f2bf(lo) | (f2bf(hi) << 16); }
__device__ __forceinline__ float bflo(unsigned w) { return __uint_as_float(w << 16); }
__device__ __forceinline__ unsigned pk2r(float a, float b) { unsigned r; asm("v_cvt_pk_bf16_f32 %0, %1, %2" : "=v"(r) : "v"(a), "v"(b)); return r; }
__device__ __forceinline__ v2u split_bf16(float a, float b) { unsigned hi, lo; asm("v_cvt_pk_bf16_f32 %0, %1, %2" : "=v"(hi) : "v"(a), "v"(b)); const float ra = a - __uint_as_float(hi << 16), rb = b - __uint_as_float(hi & 0xffff0000u); asm("v_cvt_pk_bf16_f32 %0, %1, %2" : "=v"(lo) : "v"(ra), "v"(rb)); return (v2u){hi, lo}; }
__device__ __forceinline__ float bfhi(unsigned w) { return __uint_as_float(w & 0xffff0000u); }

#define XB_TMO      128
#define XB_XCNT(j)  (256  + 64 * (j))
#define XB_XSUB(j)  (1280 + 64 * (j))
#define XB_XGEN(j)  (2304 + 64 * (j))
#define XB_TOP      3328
#define XB_TOPGEN   3392
#define XCD_BAR_WORDS 3456
#define XB_SPIN_CAP (1u << 18)
__device__ __forceinline__ unsigned xb_ld(unsigned* p)              { return __hip_atomic_load(p, __ATOMIC_RELAXED, __HIP_MEMORY_SCOPE_AGENT); }
__device__ __forceinline__ unsigned xb_add(unsigned* p, unsigned v) { return __hip_atomic_fetch_add(p, v, __ATOMIC_RELAXED, __HIP_MEMORY_SCOPE_AGENT); }
__device__ __forceinline__ unsigned xb_xcc_id() { return (unsigned)__builtin_amdgcn_s_getreg((3 << 11) | 20) & 0xFu; }
#define XB_SPIN(cond, bar) do { unsigned _sp = 0; while (cond) { __builtin_amdgcn_s_sleep(1); \
    if ((++_sp & 255u) == 0u) { if (xb_ld(&(bar)[XB_TMO])) break; if (_sp > XB_SPIN_CAP) { atomicAdd(&(bar)[XB_TMO], 1u); break; } } } } while (0)
struct XcdBarrier { unsigned* bar; unsigned x; volatile LAS unsigned* st; };
__device__ __forceinline__ XcdBarrier xcd_barrier_post(unsigned* bar, volatile LAS unsigned* st) {
    XcdBarrier b; b.bar = bar; b.x = xb_xcc_id(); b.st = st;
    if (threadIdx.x == 0) (void)xb_add(&bar[XB_XCNT(b.x)], 1u);
    return b;
}
__device__ __forceinline__ void xcd_barrier_complete(unsigned* bar, unsigned x, unsigned& nloc, unsigned& nx) {
    const unsigned G = gridDim.x * gridDim.y * gridDim.z;
    unsigned sum, cnt, mine, sp = 0u;
    for (;;) {
        sum = 0u; cnt = 0u; mine = 0u;
#pragma unroll
        for (unsigned j = 0; j < 16; ++j) { const unsigned c = xb_ld(&bar[XB_XCNT(j)]); sum += c; cnt += (c > 0u) ? 1u : 0u; mine = (j == x) ? c : mine; }
        if (sum == G) break;
        __builtin_amdgcn_s_sleep(1);
        if ((++sp & 255u) == 0u) { if (xb_ld(&bar[XB_TMO])) break; if (sp > XB_SPIN_CAP) { atomicAdd(&bar[XB_TMO], 1u); break; } }
    }
    nloc = mine > 0u ? mine : 1u; nx = cnt > 0u ? cnt : 1u;
}
__device__ __forceinline__ void xcd_barrier(const XcdBarrier& b) {
    asm volatile("s_waitcnt vmcnt(0)" ::: "memory");
    __syncthreads();
    if (threadIdx.x == 0) {
        unsigned* bar = b.bar;
        __builtin_amdgcn_s_waitcnt(0);
        unsigned nloc = b.st[0], nx = b.st[1];
        if (nloc == 0u) { xcd_barrier_complete(bar, b.x, nloc, nx); b.st[0] = nloc; b.st[1] = nx; }
        const unsigned old = xb_add(&bar[XB_XSUB(b.x)], 1u);
        const unsigned gen = old / nloc;
        if (old + 1u == (gen + 1u) * nloc) {
            __builtin_amdgcn_fence(__ATOMIC_RELEASE, "agent");
            asm volatile("s_waitcnt vmcnt(0)" ::: "memory");
            const unsigned og = xb_add(&bar[XB_TOP], 1u);
            const unsigned tg = og / nx;
            if (og + 1u == (tg + 1u) * nx) xb_add(&bar[XB_TOPGEN], 1u);
            else XB_SPIN(xb_ld(&bar[XB_TOPGEN]) == tg, bar);
            __builtin_amdgcn_fence(__ATOMIC_ACQUIRE, "agent");
            xb_add(&bar[XB_XGEN(b.x)], 1u);
            asm volatile("s_waitcnt vmcnt(0)" ::: "memory");
        } else {
            XB_SPIN(xb_ld(&bar[XB_XGEN(b.x)]) == gen, bar);
            __builtin_amdgcn_fence(__ATOMIC_ACQUIRE, "agent");
            asm volatile("s_waitcnt vmcnt(0)" ::: "memory");
        }
    }
    __syncthreads();
}

struct Frame {
    LAS unsigned char* lds;
    volatile LAS unsigned* MISC;
    gu32* ctl;
    int tid, lane, wave;
    int vcu, G;
    unsigned char* ws; float* out;
    const __attribute__((address_space(4))) char* karg;
};
#define INP(i) (*(const float* const __attribute__((address_space(4)))*)(F.karg + 8 * (i)))
enum { I_X = 0, I_C, I_WADA, I_BADA, I_WIN, I_BIN, I_CONVW, I_CONVB, I_LNAG, I_LNAB, I_WPA, I_BPA, I_LNVG, I_LNVB, I_WS, I_BS, I_WPB, I_BPB, I_WOUT, I_BOUT, I_P1G, I_P1B,
       I_WR, I_BR, I_WUP, I_BUP, I_WDN, I_BDN, I_P2G, I_P2B };

__device__ __forceinline__ float sel_mask(float a, float b, unsigned long long mask) { float r; asm volatile("v_cndmask_b32 %0, %1, %2, %3" : "=v"(r) : "v"(a), "v"(b), "s"(mask)); return r; }
#define DPP_F(v, ctrl) __builtin_bit_cast(float, __builtin_amdgcn_update_dpp(0, __builtin_bit_cast(int, (v)), (ctrl), 0xf, 0xf, true))
#define DPP_I(v, ctrl) __builtin_amdgcn_update_dpp(0, (v), (ctrl), 0xf, 0xf, true)
constexpr int DPP_XOR1 = 0xB1, DPP_XOR2 = 0x4E, DPP_HMIRROR = 0x141, DPP_MIRROR = 0x140;
__device__ __forceinline__ float wave_sum(float v) {
    v += DPP_F(v, DPP_XOR1); v += DPP_F(v, DPP_XOR2); v += DPP_F(v, DPP_HMIRROR); v += DPP_F(v, DPP_MIRROR);
    const int iv = __builtin_bit_cast(int, v);
    const float r0 = __builtin_bit_cast(float, __builtin_amdgcn_readlane(iv, 0)), r1 = __builtin_bit_cast(float, __builtin_amdgcn_readlane(iv, 16)), r2 = __builtin_bit_cast(float, __builtin_amdgcn_readlane(iv, 32)), r3 = __builtin_bit_cast(float, __builtin_amdgcn_readlane(iv, 48));
    return (r0 + r1) + (r2 + r3);
}
__device__ __forceinline__ int glu_map(int c) { if (c >= 2048) return c; const int bj = c >> 10, q = c & 1023; return ((q >> 7) << 8) + (bj << 7) + (q & 127); }

__device__ __forceinline__ void p0_transpose_item(const float* W, int K, int N, bf16* WT, int drow0, LAS float* scr, int k0, int n0, int lane) {
#pragma unroll 8
    for (int i = 0; i < 32; ++i) { const int kk = 2 * i + (lane >> 5); scr[kk * 33 + (lane & 31)] = W[(size_t)(k0 + kk) * N + n0 + (lane & 31)]; }
    LDS_WAIT(); asm volatile("" ::: "memory");
    const int c = lane & 7;
#pragma unroll
    for (int j = 0; j < 4; ++j) { const int n = (lane >> 3) + 8 * j; const LAS float* s = scr + (8 * c) * 33 + n;
        v4u o; o.x = pk2(s[0 * 33], s[1 * 33]); o.y = pk2(s[2 * 33], s[3 * 33]); o.z = pk2(s[4 * 33], s[5 * 33]); o.w = pk2(s[6 * 33], s[7 * 33]);
        *(GAS v4u*)(WT + (size_t)(drow0 + n) * K + k0 + 8 * c) = o; }
    LDS_WAIT(); asm volatile("" ::: "memory");
}

__device__ __forceinline__ void p0_transpose_item8(const float* W, int K, int N, unsigned char* WT, int drow0, LAS float* scr, int k0, int n0, int lane, float scale) {
#pragma unroll 8
    for (int i = 0; i < 32; ++i) { const int kk = 2 * i + (lane >> 5); scr[kk * 33 + (lane & 31)] = W[(size_t)(k0 + kk) * N + n0 + (lane & 31)] * scale; }
    LDS_WAIT(); asm volatile("" ::: "memory");
    const int c = lane & 3;
#pragma unroll
    for (int j = 0; j < 2; ++j) { const int n = (lane >> 2) + 16 * j; const LAS float* s = scr + (16 * c) * 33 + n;
        v4u o; o.x = pg8::pk4_fp8(s[0 * 33], s[1 * 33], s[2 * 33], s[3 * 33]); o.y = pg8::pk4_fp8(s[4 * 33], s[5 * 33], s[6 * 33], s[7 * 33]);
        o.z = pg8::pk4_fp8(s[8 * 33], s[9 * 33], s[10 * 33], s[11 * 33]); o.w = pg8::pk4_fp8(s[12 * 33], s[13 * 33], s[14 * 33], s[15 * 33]);
        *(GAS v4u*)(WT + (size_t)(drow0 + n) * K + k0 + 16 * c) = o; }
    LDS_WAIT(); asm volatile("" ::: "memory");
}

__device__ __forceinline__ void p0_prologue(Frame& F) {
    {
        LAS float* cond = (LAS float*)(F.lds + RING_OFF);
        LAS float* red = (LAS float*)(F.lds + RING_OFF + 32768);
        const float* c = INP(I_C); const float* wada = INP(I_WADA); const float* bada = INP(I_BADA); float* mod = (float*)(F.ws + WS_MOD);
        bool loaded = false;
        for (int it = blockIdx.x; it < NMOD / 32; it += F.G) {
            if (!loaded) { for (int i = F.tid; i < NBATCH * D; i += NWAVES * 64) { const float v = c[i]; cond[i] = v / (1.0f + __expf(-v)); } loaded = true; }
            __syncthreads();
            const int col = F.lane & 31, kh = F.lane >> 5, n0 = it * 32;
            float a[NBATCH];
#pragma unroll
            for (int b = 0; b < NBATCH; ++b) a[b] = 0.f;
#pragma unroll 8
            for (int i = 0; i < 64; ++i) { const int k = F.wave * 128 + 2 * i + kh; const float w = wada[(size_t)k * NMOD + n0 + col];
#pragma unroll
                for (int b = 0; b < NBATCH; ++b) a[b] += cond[b * D + k] * w; }
#pragma unroll
            for (int b = 0; b < NBATCH; ++b) { a[b] += __shfl_xor(a[b], 32); if (F.lane < 32) red[(F.wave * NBATCH + b) * 32 + col] = a[b]; }
            __syncthreads();
            if (F.tid < 256) { const int b = F.tid >> 5, cc = F.tid & 31; float s = bada[n0 + cc];
#pragma unroll
                for (int w = 0; w < NWAVES; ++w) s += red[(w * NBATCH + b) * 32 + cc];
                mod[b * NMOD + n0 + cc] = s; }
            __syncthreads();
        }
        __syncthreads();
    }
    {
        const int gt = (F.vcu * NWAVES + F.wave) * 64 + F.lane, NGT = F.G * NWAVES * 64;
        float* binp = (float*)(F.ws + WS_BINP); float* bupp = (float*)(F.ws + WS_BUPP); float* wrt = (float*)(F.ws + WS_WRT);
        for (int i = gt; i < IN_DIM; i += NGT) binp[glu_map(i)] = INP(I_BIN)[i];
        for (int i = gt; i < NE * 2048; i += NGT) { const int e = i >> 11, cc = i & 2047; bupp[e * 2048 + glu_map(cc)] = INP(I_BUP)[i]; }
        for (int i = gt; i < D * NE; i += NGT) { const int cc = i >> 5, e = i & 31; wrt[e * D + cc] = INP(I_WR)[i]; }
        bf16* wsm = (bf16*)(F.ws + WS_WSM);
        for (int i = gt; i < 8 * 128 * 128; i += NGT) { const int tt = (i >> 7) & 127, ss = i & 127; wsm[i] = (bf16)f2bf(ss <= tt ? INP(I_WS)[i] : 0.f); }
    }
    {
        LAS float* scr = (LAS float*)(F.lds + RING_OFF + F.wave * 16384);
        const int gw = F.vcu * NWAVES + F.wave, NGW = F.G * NWAVES;
        constexpr int I_IN = 16 * 192, I_SQ = 16 * 32, I_UP = NE * 16 * 64, I_DN = NE * 16 * 32;
        constexpr int NITEMS = I_IN + 3 * I_SQ + I_UP + I_DN;
        for (int it = gw; it < NITEMS; it += NGW) {
            int r = it;
            if (r < I_IN) { const int kb = r / 192, nb = r % 192; p0_transpose_item8(INP(I_WIN), D, IN_DIM, (unsigned char*)(F.ws + WS_WIN), glu_map(32 * nb), scr, 64 * kb, 32 * nb, F.lane, pg8::W8_SCALE); continue; } r -= I_IN;
            if (r < I_SQ) { const int kb = r / 32, nb = r % 32; p0_transpose_item8(INP(I_WPA), D, D, (unsigned char*)(F.ws + WS_WPA), 32 * nb, scr, 64 * kb, 32 * nb, F.lane, pg8::W8_SCALE); continue; } r -= I_SQ;
            if (r < I_SQ) { const int kb = r / 32, nb = r % 32; p0_transpose_item8(INP(I_WPB), D, D, (unsigned char*)(F.ws + WS_WPB), 32 * nb, scr, 64 * kb, 32 * nb, F.lane, pg8::W8_SCALE); continue; } r -= I_SQ;
            if (r < I_SQ) { const int kb = r / 32, nb = r % 32; p0_transpose_item8(INP(I_WOUT), D, D, (unsigned char*)(F.ws + WS_WOUT), 32 * nb, scr, 64 * kb, 32 * nb, F.lane, pg8::W8_SCALE); continue; } r -= I_SQ;
            if (r < I_UP) { const int e = r >> 10, rr = r & 1023, kb = rr >> 6, nb = rr & 63;
                p0_transpose_item8(INP(I_WUP) + (size_t)e * D * 2048, D, 2048, (unsigned char*)(F.ws + WS_WUP) + (size_t)e * 2048 * D, glu_map(32 * nb), scr, 64 * kb, 32 * nb, F.lane, pg8::W8_SCALE); continue; } r -= I_UP;
            { const int e = r >> 9, rr = r & 511, kb = rr >> 5, nb = rr & 31;
                p0_transpose_item8(INP(I_WDN) + (size_t)e * D * D, D, D, (unsigned char*)(F.ws + WS_WDN) + (size_t)e * D * D, 32 * nb, scr, 64 * kb, 32 * nb, F.lane, pg8::W8_SCALE); }
        }
    }
}

__device__ __forceinline__ void p1_lnmod(Frame& F) {
    const int gw = F.vcu * NWAVES + F.wave, NGW = F.G * NWAVES, RPW = (T + NGW - 1) / NGW;
    const int r0 = gw * RPW, r1 = (r0 + RPW) < T ? (r0 + RPW) : T;
    const float* mod = (const float*)(F.ws + WS_MOD); unsigned char* H = (unsigned char*)(F.ws + WS_H);
    int curb = -1; f32x4 sc[4], sh[4];
    for (int r = r0; r < r1; ++r) {
        const int b = r >> 12;
        if (b != curb) { curb = b;
#pragma unroll
            for (int j = 0; j < 4; ++j) { sc[j] = *(const f32x4*)(mod + b * NMOD + MOD_SCALE1 + 4 * F.lane + 256 * j) + 1.0f; sh[j] = *(const f32x4*)(mod + b * NMOD + MOD_SHIFT1 + 4 * F.lane + 256 * j); } }
        const f32x4* xr = (const f32x4*)(INP(I_X) + (size_t)r * D) + F.lane;
        f32x4 v[4]; float s = 0.f;
#pragma unroll
        for (int j = 0; j < 4; ++j) { v[j] = xr[64 * j]; s += (v[j].x + v[j].y) + (v[j].z + v[j].w); }
        const float mean = wave_sum(s) * (1.f / D); float s2 = 0.f;
#pragma unroll
        for (int j = 0; j < 4; ++j) { v[j] = v[j] - mean; s2 += (v[j].x * v[j].x + v[j].y * v[j].y) + (v[j].z * v[j].z + v[j].w * v[j].w); }
        const float rstd = __builtin_amdgcn_rsqf(wave_sum(s2) * (1.f / D) + LN_EPS);
        unsigned* o4 = (unsigned*)(H + (size_t)r * D) + F.lane;
#pragma unroll
        for (int j = 0; j < 4; ++j) { const f32x4 h = v[j] * rstd * sc[j] + sh[j]; o4[64 * j] = pg8::pk4_fp8(h.x, h.y, h.z, h.w); }
    }
}

__device__ __forceinline__ void p3_conv_unit(Frame& F, int u) {
    const int c0 = 2 * F.tid, g0 = u * 128, t0 = (u & 31) * 128;
    const bf16* Z = (const bf16*)(F.ws + WS_Z); unsigned char* AACT = (unsigned char*)(F.ws + WS_AACT);
    LAS float* wl = (LAS float*)(F.lds + RING_OFF);
    LAS float* red = (LAS float*)(F.lds + RING_OFF + 126976);
    { const f32x4* wsrc = (const f32x4*)INP(I_CONVW); f32x4 t[16];
#pragma unroll
      for (int k = 0; k < 16; ++k) { const int i = F.tid + k * NWAVES * 64; t[k] = wsrc[i < 31 * D / 4 ? i : F.tid]; }
#pragma unroll
      for (int k = 0; k < 16; ++k) { const int i = F.tid + k * NWAVES * 64; if (i < 31 * D / 4) ((LAS f32x4*)wl)[i] = t[k]; } }
    __syncthreads();
    unsigned wa_off = (unsigned)(RING_OFF + c0 * 4), wb_off = (unsigned)(RING_OFF + 16 * D * 4 + c0 * 4);
    asm volatile("" : "+v"(wa_off), "+v"(wb_off));
    const LAS unsigned char* wA = F.lds + wa_off; const LAS unsigned char* wB = F.lds + wb_off;
    const f32x2 cb = *(const f32x2*)(INP(I_CONVB) + c0), lg = *(const f32x2*)(INP(I_LNAG) + c0), lb = *(const f32x2*)(INP(I_LNAB) + c0);
    f32x2 zp[38]; unsigned zn[8];
    { const bf16* zh = Z + (size_t)(t0 > 0 ? g0 - 30 : g0) * D + c0; const unsigned msk = t0 > 0 ? 0xffffffffu : 0u;
#pragma unroll
      for (int i = 0; i < 30; ++i) { const unsigned p = *(const unsigned*)(zh + (size_t)i * D) & msk; zp[i] = (f32x2){bflo(p), bfhi(p)}; }
      const bf16* zr = Z + (size_t)g0 * D + c0;
#pragma unroll
      for (int r = 0; r < 8; ++r) zn[r] = *(const unsigned*)(zr + (size_t)r * D); }
#pragma unroll 1
    for (int ch = 0; ch < 16; ++ch) {
        unsigned char* orow = AACT + (size_t)(g0 + ch * 8) * D + c0;
#pragma unroll
        for (int r = 0; r < 8; ++r) zp[30 + r] = (f32x2){bflo(zn[r]), bfhi(zn[r])};
        { const bf16* zr = Z + (size_t)(g0 + (ch < 15 ? ch + 1 : ch) * 8) * D + c0;
#pragma unroll
          for (int r = 0; r < 8; ++r) zn[r] = *(const unsigned*)(zr + (size_t)r * D); }
        f32x2 op[8]; float sv[16];
#pragma unroll
        for (int r = 0; r < 8; ++r) op[r] = cb;
#pragma unroll
        for (int j = 0; j < 31; ++j) { const f32x2 w = (j < 16) ? *(const LAS f32x2*)(wA + j * D * 4) : *(const LAS f32x2*)(wB + (j - 16) * D * 4);
#pragma unroll
            for (int r = 0; r < 8; ++r) op[r] = __builtin_elementwise_fma(w, zp[r + j], op[r]);
            if ((j & 7) == 7) __builtin_amdgcn_sched_barrier(0); }
#pragma unroll
        for (int r = 0; r < 8; ++r) { const f32x2 q = op[r] * op[r]; sv[r] = op[r].x + op[r].y; sv[8 + r] = q.x + q.y; }
#define TR_STEP(o, n, mk) { unsigned long long m_ = (mk); asm volatile("" : "+s"(m_)); _Pragma("unroll") for (int k = 0; k < (n); ++k) { const float keep = sel_mask(sv[k], sv[k + (n)], m_), give = sel_mask(sv[k + (n)], sv[k], m_); sv[k] = keep + __shfl_xor(give, (o)); } }
        TR_STEP(32, 8, 0xFFFFFFFF00000000ull) TR_STEP(16, 4, 0xFFFF0000FFFF0000ull) TR_STEP(8, 2, 0xFF00FF00FF00FF00ull) TR_STEP(4, 1, 0xF0F0F0F0F0F0F0F0ull)
#undef TR_STEP
        sv[0] += __shfl_xor(sv[0], 2); sv[0] += __shfl_xor(sv[0], 1);
        LAS float* rd = red + (ch & 1) * 128;
        if ((F.lane & 3) == 0) rd[F.wave * 16 + (F.lane >> 2)] = sv[0];
        __syncthreads();
        f32x4 tq[4] = {{0.f, 0.f, 0.f, 0.f}, {0.f, 0.f, 0.f, 0.f}, {0.f, 0.f, 0.f, 0.f}, {0.f, 0.f, 0.f, 0.f}};
#pragma unroll
        for (int w = 0; w < NWAVES; ++w)
#pragma unroll
            for (int v4 = 0; v4 < 4; ++v4) tq[v4] += *(const LAS f32x4*)(rd + w * 16 + 4 * v4);
#pragma unroll
        for (int r = 0; r < 8; ++r) { const float mean = tq[r >> 2][r & 3] * (1.f / D), var = tq[2 + (r >> 2)][r & 3] * (1.f / D) - mean * mean, rstd = __builtin_amdgcn_rsqf(fmaxf(var, 0.f) + LN_EPS);
            const f32x2 y = (op[r] - mean) * rstd * lg + lb;
            const f32x2 e = {__builtin_amdgcn_exp2f(-1.44269504089f * y.x), __builtin_amdgcn_exp2f(-1.44269504089f * y.y)}; const f32x2 d = e + 1.0f;
            const f32x2 o = y * (f32x2){__builtin_amdgcn_rcpf(d.x), __builtin_amdgcn_rcpf(d.y)};
            *(unsigned short*)(orow + (size_t)r * D) = (unsigned short)pg8::pk4_fp8_raw(o.x, o.y, 0.f, 0.f); }
#pragma unroll
        for (int i = 0; i < 30; ++i) zp[i] = zp[i + 8];
    }
    __syncthreads();
}

template <int OFF> __device__ __forceinline__ void tr_read8(v2u (&r)[8], const unsigned (&a)[8]) {
    asm volatile("ds_read_b64_tr_b16 %0, %8 offset:%16\n\tds_read_b64_tr_b16 %1, %9 offset:%16\n\tds_read_b64_tr_b16 %2, %10 offset:%16\n\tds_read_b64_tr_b16 %3, %11 offset:%16\n\t"
                 "ds_read_b64_tr_b16 %4, %12 offset:%16\n\tds_read_b64_tr_b16 %5, %13 offset:%16\n\tds_read_b64_tr_b16 %6, %14 offset:%16\n\tds_read_b64_tr_b16 %7, %15 offset:%16\n\ts_waitcnt lgkmcnt(0)"
                 : "=&v"(r[0]), "=&v"(r[1]), "=&v"(r[2]), "=&v"(r[3]), "=&v"(r[4]), "=&v"(r[5]), "=&v"(r[6]), "=&v"(r[7])
                 : "v"(a[0]), "v"(a[1]), "v"(a[2]), "v"(a[3]), "v"(a[4]), "v"(a[5]), "v"(a[6]), "v"(a[7]), "i"(OFF) : "memory");
}
template <int KS> __device__ __forceinline__ void mix_kstep(f32x4 (&acc)[8], const LAS unsigned short* Wl, int wrow, int fq, const unsigned (&a0)[8], const unsigned (&a1)[8]) {
    const bf16x8 wf = *(const LAS bf16x8*)(Wl + wrow * 136 + 32 * KS + 8 * fq);
    v2u r0[8], r1[8];
    tr_read8<KS * 8192>(r0, a0); tr_read8<KS * 8192 + 1024>(r1, a1);
    __builtin_amdgcn_sched_barrier(0);
#pragma unroll
    for (int c = 0; c < 8; ++c) { const v4u vv = {r0[c].x, r0[c].y, r1[c].x, r1[c].y}; acc[c] = __builtin_amdgcn_mfma_f32_16x16x32_bf16((bf16x8)vv, wf, acc[c], 0, 0, 0); }
}
__device__ __forceinline__ void p3_mix_unit(Frame& F, int u) {
    constexpr int LP = 136, VS_OFF = 34816, ST_OFF = 67584;
    LAS unsigned short* Wl = (LAS unsigned short*)(F.lds + RING_OFF);
    LAS unsigned char* Vs = F.lds + RING_OFF + VS_OFF;
    LAS float* st = (LAS float*)(F.lds + RING_OFF + ST_OFF);
    const bf16* GV = (const bf16*)(F.ws + WS_GV); const bf16* GU = (const bf16*)(F.ws + WS_GU); unsigned char* GATED = (unsigned char*)(F.ws + WS_GATED); const bf16* WSM = (const bf16*)(F.ws + WS_WSM);
    const int g0 = u * 128, fr = F.lane & 15, fq = F.lane >> 4;
#pragma unroll 1
    for (int hb = 0; hb < 2; ++hb) {
        v4u ra[8], rb[8];
#pragma unroll
        for (int i = 0; i < 8; ++i) { const bf16* row = GV + (size_t)(g0 + F.wave * 16 + hb * 8 + i) * D; ra[i] = *(const v4u*)(row + 8 * F.lane); rb[i] = *(const v4u*)(row + 512 + 8 * F.lane); }
        float sv[16];
#pragma unroll
        for (int i = 0; i < 8; ++i) { float sm = 0.f, sq = 0.f;
#pragma unroll
            for (int j = 0; j < 4; ++j) { const float x0 = bflo(ra[i][j]), x1 = bfhi(ra[i][j]), x2 = bflo(rb[i][j]), x3 = bfhi(rb[i][j]); sm += (x0 + x1) + (x2 + x3); sq += (x0 * x0 + x1 * x1) + (x2 * x2 + x3 * x3); }
            sv[i] = sm; sv[8 + i] = sq; }
#define TR_STEP(o, n, mk) { unsigned long long m_ = (mk); asm volatile("" : "+s"(m_)); _Pragma("unroll") for (int k = 0; k < (n); ++k) { const float keep = sel_mask(sv[k], sv[k + (n)], m_), give = sel_mask(sv[k + (n)], sv[k], m_); sv[k] = keep + __shfl_xor(give, (o)); } }
        TR_STEP(32, 8, 0xFFFFFFFF00000000ull) TR_STEP(16, 4, 0xFFFF0000FFFF0000ull) TR_STEP(8, 2, 0xFF00FF00FF00FF00ull) TR_STEP(4, 1, 0xF0F0F0F0F0F0F0F0ull)
#undef TR_STEP
        sv[0] += __shfl_xor(sv[0], 2); sv[0] += __shfl_xor(sv[0], 1);
        const float other = __shfl_xor(sv[0], 32);
        if (F.lane < 32 && (F.lane & 3) == 0) { const int s = F.wave * 16 + hb * 8 + (F.lane >> 2); const float mu = sv[0] * (1.f / D), var = other * (1.f / D) - mu * mu; st[s] = mu; st[128 + s] = __builtin_amdgcn_rsqf(fmaxf(var, 0.f) + LN_EPS); }
    }
    unsigned a0[8], a1[8];
    { const unsigned g = F.lane >> 4, q = (F.lane & 15) >> 2, p = F.lane & 3, lb = (unsigned)(unsigned long)Vs + 256u * (8u * g + q) + 8u * (p & 1), x0 = (q << 2) | ((2u * g) & 3u), x1 = (q << 2) | ((2u * g + 1u) & 3u);
#pragma unroll
      for (int c = 0; c < 8; ++c) { a0[c] = lb + 16u * ((2u * c + (p >> 1)) ^ x0); a1[c] = lb + 16u * ((2u * c + (p >> 1)) ^ x1); } }
    const int rr = F.tid >> 4, cc = F.tid & 15;
    v4u wreg[4], vreg[4]; v2u gu[8];
    const int t = 16 * F.wave + fr;
#define MIX_LOAD(h) do { _Pragma("unroll") for (int i = 0; i < 4; ++i) { wreg[i] = *(const v4u*)(WSM + (size_t)(h) * 16384 + (rr + 32 * i) * 128 + cc * 8); vreg[i] = *(const v4u*)(GV + (size_t)(g0 + rr + 32 * i) * D + (h) * 128 + cc * 8); } \
        _Pragma("unroll") for (int dn = 0; dn < 8; ++dn) gu[dn] = *(const v2u*)(GU + (size_t)(g0 + t) * D + (h) * 128 + 16 * dn + 4 * fq); } while (0)
    MIX_LOAD(0);
    __syncthreads();
    for (int h = 0; h < 8; ++h) {
        { const f32x4 g0v = *(const f32x4*)(INP(I_LNVG) + h * 128 + cc * 8), g1v = *(const f32x4*)(INP(I_LNVG) + h * 128 + cc * 8 + 4), b0v = *(const f32x4*)(INP(I_LNVB) + h * 128 + cc * 8), b1v = *(const f32x4*)(INP(I_LNVB) + h * 128 + cc * 8 + 4);
#pragma unroll
          for (int i = 0; i < 4; ++i) { const int s = rr + 32 * i;
            *(LAS v4u*)(Wl + s * LP + cc * 8) = wreg[i];
            const float mu = st[s], rs = st[128 + s];
            f32x4 x0 = {bflo(vreg[i].x), bfhi(vreg[i].x), bflo(vreg[i].y), bfhi(vreg[i].y)}, x1 = {bflo(vreg[i].z), bfhi(vreg[i].z), bflo(vreg[i].w), bfhi(vreg[i].w)};
            x0 = (x0 - mu) * rs * g0v + b0v; x1 = (x1 - mu) * rs * g1v + b1v;
            v4u o; o.x = pk2(x0.x, x0.y); o.y = pk2(x0.z, x0.w); o.z = pk2(x1.x, x1.y); o.w = pk2(x1.z, x1.w);
            *(LAS v4u*)(Vs + 256 * s + 16 * (cc ^ (((s & 3) << 2) | ((s >> 2) & 3)))) = o; } }
        v2u guc[8];
#pragma unroll
        for (int dn = 0; dn < 8; ++dn) guc[dn] = gu[dn];
        const float bs = INP(I_BS)[h * 128 + t];
        if (h < 7) MIX_LOAD(h + 1);
        __syncthreads();
        f32x4 acc[8];
#pragma unroll
        for (int c = 0; c < 8; ++c) acc[c] = (f32x4){0.f, 0.f, 0.f, 0.f};
        const int ksmax = F.wave >> 1;
        mix_kstep<0>(acc, Wl, 16 * F.wave + fr, fq, a0, a1);
        if (ksmax >= 1) mix_kstep<1>(acc, Wl, 16 * F.wave + fr, fq, a0, a1);
        if (ksmax >= 2) mix_kstep<2>(acc, Wl, 16 * F.wave + fr, fq, a0, a1);
        if (ksmax >= 3) mix_kstep<3>(acc, Wl, 16 * F.wave + fr, fq, a0, a1);
#pragma unroll
        for (int dn = 0; dn < 8; ++dn) { const size_t off = (size_t)(g0 + t) * D + h * 128 + 16 * dn + 4 * fq;
            const f32x4 gq = {bflo(guc[dn].x), bfhi(guc[dn].x), bflo(guc[dn].y), bfhi(guc[dn].y)}; const f32x4 o = (acc[dn] + bs) * gq;
            *(unsigned*)(GATED + off) = pg8::pk4_fp8(o.x, o.y, o.z, o.w); }
        __syncthreads();
    }
#undef MIX_LOAD
}

__device__ __forceinline__ void moe_tables(Frame& F) {
    LAS int* cnt = (LAS int*)(F.lds + TBL_CNT); LAS int* rs = (LAS int*)(F.lds + TBL_RS); LAS int* tpu = (LAS int*)(F.lds + TBL_TPU); LAS int* tpd = (LAS int*)(F.lds + TBL_TPD);
    if (F.tid == 0) { int r = 0, a = 0, b = 0;
        for (int e = 0; e < NE; ++e) { const int c = (int)__hip_atomic_load(F.ctl + CW_ECNT + e, RLX_AGENT); const int tiles = (c + 255) >> 8; cnt[e] = c; rs[e] = r; tpu[e] = a; tpd[e] = b; r += c; a += tiles * 8; b += tiles * 4; }
        rs[NE] = r; tpu[NE] = a; tpd[NE] = b; }
    __syncthreads();
}

struct RowIn { f32x4 x[4]; unsigned y[4]; };
__device__ __forceinline__ void row_load(RowIn& R, const float* x, const unsigned char* YO, int r, int lane) {
    const f32x4* xr = (const f32x4*)(x + (size_t)r * D) + lane; const unsigned* yr = (const unsigned*)(YO + (size_t)r * D) + lane;
#pragma unroll
    for (int j = 0; j < 4; ++j) { R.x[j] = xr[64 * j]; R.y[j] = yr[64 * j]; }
}
__device__ __forceinline__ void ln_inplace(f32x4 (&v)[4]) {
    float s = 0.f;
#pragma unroll
    for (int j = 0; j < 4; ++j) s += (v[j].x + v[j].y) + (v[j].z + v[j].w);
    const float mean = wave_sum(s) * (1.f / D); float s2 = 0.f;
#pragma unroll
    for (int j = 0; j < 4; ++j) { v[j] = v[j] - mean; s2 += (v[j].x * v[j].x + v[j].y * v[j].y) + (v[j].z * v[j].z + v[j].w * v[j].w); }
    const float rstd = __builtin_amdgcn_rsqf(wave_sum(s2) * (1.f / D) + LN_EPS);
#pragma unroll
    for (int j = 0; j < 4; ++j) v[j] = v[j] * rstd;
}
__device__ __forceinline__ void row_x1(const RowIn& R, f32x4 (&v)[4], const LAS float* g1, const LAS float* b1, int lane) {
#pragma unroll
    for (int j = 0; j < 4; ++j) { const f32x2 lo = __builtin_amdgcn_cvt_pk_f32_fp8((int)R.y[j], false), hi = __builtin_amdgcn_cvt_pk_f32_fp8((int)R.y[j], true); v[j] = R.x[j] * DN_ALPHA + (f32x4){lo.x, lo.y, hi.x, hi.y} * (1.0f / pg8::YO8_SCALE); }
    ln_inplace(v);
#pragma unroll
    for (int j = 0; j < 4; ++j) v[j] = v[j] * *(const LAS f32x4*)(g1 + 4 * lane + 256 * j) + *(const LAS f32x4*)(b1 + 4 * lane + 256 * j);
}

__device__ __forceinline__ void p6_router(Frame& F) {
    LAS int* lcnt = (LAS int*)(F.lds + RT_CNT); LAS int* lbase = (LAS int*)(F.lds + RT_BASE); LAS int* rece = (LAS int*)(F.lds + RT_RECE); LAS int* recl = (LAS int*)(F.lds + RT_RECL); LAS float* recw = (LAS float*)(F.lds + RT_RECW);
    const float* mod = (const float*)(F.ws + WS_MOD); unsigned char* H2 = (unsigned char*)(F.ws + WS_H2);
    const unsigned char* YO = (const unsigned char*)(F.ws + WS_YO); const float* xin = INP(I_X); bf16* X1 = (bf16*)(F.ws + WS_X1);
    LAS float* pv = (LAS float*)(F.lds + PV6_OFF); const LAS float* g1 = pv; const LAS float* b1 = pv + D;
    v4u* tok = (v4u*)(F.ws + WS_TOK); int* list = (int*)(F.ws + WS_LIST);
    constexpr int HP = 2080, HLO = 16 * HP, PART = 2 * HLO;
    LAS unsigned char* hst = F.lds + RING_OFF; LAS float* part = (LAS float*)(F.lds + RING_OFF + PART);
    const int fr = F.lane & 15, fq = F.lane >> 4;
    bf16x8 whi[2][4], wlo[2][4];
    { const float* wsrc = (const float*)(F.ws + WS_WRT);
#pragma unroll
      for (int et = 0; et < 2; ++et)
#pragma unroll
          for (int ks = 0; ks < 4; ++ks) { const f32x4* pw = (const f32x4*)(wsrc + (size_t)(16 * et + fr) * D + F.wave * 128 + 32 * ks + 8 * fq); const f32x4 x0 = pw[0], x1 = pw[1];
              const v2u s0 = split_bf16(x0.x, x0.y), s1 = split_bf16(x0.z, x0.w), s2 = split_bf16(x1.x, x1.y), s3 = split_bf16(x1.z, x1.w); whi[et][ks] = (bf16x8)(v4u){s0.x, s1.x, s2.x, s3.x}; wlo[et][ks] = (bf16x8)(v4u){s0.y, s1.y, s2.y, s3.y}; } }
    for (int rb = blockIdx.x; rb < T / 128; rb += F.G) {
        const int b = (rb * 128) >> 12, rw0 = rb * 128 + F.wave * 16;
        if (F.tid < NE) lcnt[F.tid] = 0;
        for (int i = F.tid; i < D; i += NWAVES * 64) { pv[i] = INP(I_P1G)[i]; pv[D + i] = INP(I_P1B)[i]; pv[2 * D + i] = mod[b * NMOD + MOD_SCALE2 + i] + 1.0f; pv[3 * D + i] = mod[b * NMOD + MOD_SHIFT2 + i]; }
        __syncthreads();
        RowIn RA, RB; row_load(RA, xin, YO, rw0, F.lane); row_load(RB, xin, YO, rw0 + 1, F.lane);
#pragma unroll 1
        for (int pr = 0; pr < 8; ++pr) {
            const int rl0 = F.wave * 16 + 2 * pr;
            f32x4 h[2][4];
#pragma unroll
            for (int q = 0; q < 2; ++q) {
                const int r = rb * 128 + rl0 + q;
                row_x1(q ? RB : RA, h[q], g1, b1, F.lane);
                { v2u* x1p = (v2u*)(X1 + (size_t)r * D) + F.lane;
#pragma unroll
                  for (int j = 0; j < 4; ++j) x1p[64 * j] = (v2u){pk2r(h[q][j].x, h[q][j].y), pk2r(h[q][j].z, h[q][j].w)}; }
                ln_inplace(h[q]);
                unsigned* o4 = (unsigned*)(H2 + (size_t)r * D) + F.lane;
#pragma unroll
                for (int j = 0; j < 4; ++j) { const f32x4 sc = *(const LAS f32x4*)(pv + 2 * D + 4 * F.lane + 256 * j), sh = *(const LAS f32x4*)(pv + 3 * D + 4 * F.lane + 256 * j);
                    h[q][j] = h[q][j] * sc + sh; o4[64 * j] = pg8::pk4_fp8(h[q][j].x, h[q][j].y, h[q][j].z, h[q][j].w); }
            }
            { const int rn = rw0 + (pr < 7 ? 2 * pr + 2 : 2 * pr); row_load(RA, xin, YO, rn, F.lane); row_load(RB, xin, YO, rn + 1, F.lane); }
#pragma unroll
            for (int q = 0; q < 2; ++q)
#pragma unroll
                for (int j = 0; j < 4; ++j) { const v2u s0 = split_bf16(h[q][j].x, h[q][j].y), s1 = split_bf16(h[q][j].z, h[q][j].w);
                    LAS unsigned char* d = hst + (2 * F.wave + q) * HP + (4 * F.lane + 256 * j) * 2; *(LAS v2u*)d = (v2u){s0.x, s1.x}; *(LAS v2u*)(d + HLO) = (v2u){s0.y, s1.y}; }
            LDS_WAIT(); __syncthreads();
            f32x4 lacc[2] = {{0.f, 0.f, 0.f, 0.f}, {0.f, 0.f, 0.f, 0.f}};
#pragma unroll
            for (int ks = 0; ks < 4; ++ks) { const LAS unsigned char* ap = hst + fr * HP + (F.wave * 128 + 32 * ks + 8 * fq) * 2; const bf16x8 ahi = *(const LAS bf16x8*)ap, alo = *(const LAS bf16x8*)(ap + HLO);
#pragma unroll
                for (int et = 0; et < 2; ++et) { lacc[et] = __builtin_amdgcn_mfma_f32_16x16x32_bf16(ahi, whi[et][ks], lacc[et], 0, 0, 0); lacc[et] = __builtin_amdgcn_mfma_f32_16x16x32_bf16(ahi, wlo[et][ks], lacc[et], 0, 0, 0); lacc[et] = __builtin_amdgcn_mfma_f32_16x16x32_bf16(alo, whi[et][ks], lacc[et], 0, 0, 0); } }
#pragma unroll
            for (int et = 0; et < 2; ++et)
#pragma unroll
                for (int r4 = 0; r4 < 4; ++r4) part[(F.wave * 16 + 4 * fq + r4) * 33 + 16 * et + fr] = lacc[et][r4];
            LDS_WAIT(); __syncthreads();
            float lsum = 0.f;
            { const int e_ = F.lane & 31, q_ = F.lane >> 5;
#pragma unroll
              for (int w_ = 0; w_ < NWAVES; ++w_) lsum += part[(w_ * 16 + 2 * F.wave + q_) * 33 + e_]; }
            const int e = F.lane & 31, q = F.lane >> 5; const float logit = lsum + INP(I_BR)[e];
            float tv[4]; int ti[4]; bool sel = false; int myk = 0;
#pragma unroll
            for (int k = 0; k < 4; ++k) { float cv = sel ? -3.0e38f : logit; int ci = e;
#define TK_STEP(ctrl) { const float ov = DPP_F(cv, ctrl); const int oi = DPP_I(ci, ctrl); if (ov > cv || (ov == cv && oi < ci)) { cv = ov; ci = oi; } }
                TK_STEP(DPP_XOR1) TK_STEP(DPP_XOR2) TK_STEP(DPP_HMIRROR) TK_STEP(DPP_MIRROR)
#undef TK_STEP
                { const int icv = __builtin_bit_cast(int, cv);
                  const float a0 = __builtin_bit_cast(float, __builtin_amdgcn_readlane(icv, 0)), a1 = __builtin_bit_cast(float, __builtin_amdgcn_readlane(icv, 16)), a2 = __builtin_bit_cast(float, __builtin_amdgcn_readlane(icv, 32)), a3 = __builtin_bit_cast(float, __builtin_amdgcn_readlane(icv, 48));
                  const int i0 = __builtin_amdgcn_readlane(ci, 0), i1 = __builtin_amdgcn_readlane(ci, 16), i2 = __builtin_amdgcn_readlane(ci, 32), i3 = __builtin_amdgcn_readlane(ci, 48);
                  const bool f01 = (a0 > a1 || (a0 == a1 && i0 < i1)), f23 = (a2 > a3 || (a2 == a3 && i2 < i3));
                  const float m01 = f01 ? a0 : a1, m23 = f23 ? a2 : a3; const int j01 = f01 ? i0 : i1, j23 = f23 ? i2 : i3;
                  cv = q ? m23 : m01; ci = q ? j23 : j01; }
                tv[k] = cv; ti[k] = ci; if (ci == e) { sel = true; myk = k; } }
            const float p1 = __expf(tv[1] - tv[0]), p2 = __expf(tv[2] - tv[0]), p3 = __expf(tv[3] - tv[0]), inv = 1.0f / (1.0f + p1 + p2 + p3);
            if (sel) { const float wk = (myk == 0 ? 1.0f : (myk == 1 ? p1 : (myk == 2 ? p2 : p3))) * inv; const int r = rb * 128 + rl0 + q;
                const int lr = __hip_atomic_fetch_add(lcnt + e, 1, __ATOMIC_RELAXED, __HIP_MEMORY_SCOPE_WORKGROUP);
                rece[(rl0 + q) * 4 + myk] = e; recl[(rl0 + q) * 4 + myk] = lr; recw[(rl0 + q) * 4 + myk] = wk; }
        }
        __syncthreads();
        if (F.tid < NE) lbase[F.tid] = (int)__hip_atomic_fetch_add(F.ctl + CW_ECNT + F.tid, (unsigned)lcnt[F.tid], RLX_AGENT);
        __syncthreads();
        { const int i = F.tid; const int e = rece[i], rank = lbase[e] + recl[i], r = rb * 128 + (i >> 2); tok[r * 4 + (i & 3)] = (v4u){(unsigned)e, (unsigned)rank, __float_as_uint(recw[i]), 0u}; list[(size_t)e * T + rank] = r; }
        __syncthreads();
    }
}

__device__ __forceinline__ void p10_combine(Frame& F) {
    const LAS int* rs = (const LAS int*)(F.lds + TBL_RS);
    const int gw = F.vcu * NWAVES + F.wave, NGW = F.G * NWAVES, RPW = (T + NGW - 1) / NGW;
    const int r0 = gw * RPW, r1 = (r0 + RPW) < T ? (r0 + RPW) : T;
    const float* mod = (const float*)(F.ws + WS_MOD); const unsigned char* Y = (const unsigned char*)(F.ws + WS_Y);
    const bf16* X1 = (const bf16*)(F.ws + WS_X1);
    LAS float* pv = (LAS float*)(F.lds + RING_OFF); const LAS float* g1 = pv; const LAS float* b1 = pv + D;
    { const int bb = (F.vcu * NWAVES * RPW) >> 12;
      for (int i = F.tid; i < D; i += NWAVES * 64) { pv[i] = INP(I_P1G)[i]; pv[D + i] = INP(I_P1B)[i]; pv[2 * D + i] = INP(I_P2G)[i]; pv[3 * D + i] = INP(I_P2B)[i]; pv[4 * D + i] = mod[bb * NMOD + MOD_GATE2 + i]; }
      __syncthreads(); }
    const v4u* tok = (const v4u*)(F.ws + WS_TOK);
    if (r0 >= r1) return;
    v2u XA[4], XB[4]; int ev[2], rv[2]; float wv[2];
#define P10_LOAD(r) do { const int ra_ = (r), rb_ = (ra_ + 1 < r1) ? ra_ + 1 : ra_; { const v2u* pa_ = (const v2u*)(X1 + (size_t)ra_ * D) + F.lane; const v2u* pb_ = (const v2u*)(X1 + (size_t)rb_ * D) + F.lane; _Pragma("unroll") for (int j_ = 0; j_ < 4; ++j_) { XA[j_] = pa_[64 * j_]; XB[j_] = pb_[64 * j_]; } } \
        const v4u t0_ = tok[ra_ * 4 + (F.lane & 3)], t1_ = tok[rb_ * 4 + (F.lane & 3)]; ev[0] = (int)t0_[0]; rv[0] = (int)t0_[1]; wv[0] = __uint_as_float(t0_[2]); ev[1] = (int)t1_[0]; rv[1] = (int)t1_[1]; wv[1] = __uint_as_float(t1_[2]); } while (0)
    P10_LOAD(r0);
#pragma unroll 1
    for (int r = r0; r < r1; r += 2) {
        const bool two = (r + 1 < r1);
        unsigned yv[2][4][4]; float wk[2][4];
#pragma unroll
        for (int q = 0; q < 2; ++q) { const int yrow_l = rs[ev[q]] + rv[q];
#pragma unroll
            for (int k = 0; k < 4; ++k) { const int yr = __shfl(yrow_l, k); wk[q][k] = __shfl(wv[q], k) * (1.0f / pg8::Y8_SCALE); const unsigned* yp = (const unsigned*)(Y + (size_t)yr * D) + F.lane;
#pragma unroll
                for (int j = 0; j < 4; ++j) yv[q][k][j] = yp[64 * j]; } }
        f32x4 v[2][4];
#pragma unroll
        for (int j = 0; j < 4; ++j) { v[0][j] = (f32x4){bflo(XA[j].x), bfhi(XA[j].x), bflo(XA[j].y), bfhi(XA[j].y)}; v[1][j] = (f32x4){bflo(XB[j].x), bfhi(XB[j].x), bflo(XB[j].y), bfhi(XB[j].y)}; }
        if (r + 2 < r1) P10_LOAD(r + 2);
#pragma unroll
        for (int q = 0; q < 2; ++q) {
#pragma unroll
            for (int j = 0; j < 4; ++j) { f32x2 yl = {0.f, 0.f}, yh = {0.f, 0.f};
#pragma unroll
                for (int k = 0; k < 4; ++k) { const unsigned w = yv[q][k][j]; const f32x2 lo = __builtin_amdgcn_cvt_pk_f32_fp8((int)w, false), hi = __builtin_amdgcn_cvt_pk_f32_fp8((int)w, true); const f32x2 wk2 = {wk[q][k], wk[q][k]};
                    yl = __builtin_elementwise_fma(wk2, lo, yl); yh = __builtin_elementwise_fma(wk2, hi, yh); }
                v[q][j] = v[q][j] * DN_ALPHA + *(const LAS f32x4*)(pv + 4 * D + 4 * F.lane + 256 * j) * (f32x4){yl.x, yl.y, yh.x, yh.y}; }
            ln_inplace(v[q]);
            if (q == 0 || two) { f32x4* orow = (f32x4*)(F.out + (size_t)(r + q) * D) + F.lane;
#pragma unroll
                for (int j = 0; j < 4; ++j) orow[64 * j] = v[q][j] * *(const LAS f32x4*)(pv + 2 * D + 4 * F.lane + 256 * j) + *(const LAS f32x4*)(pv + 3 * D + 4 * F.lane + 256 * j); }
        }
    }
#undef P10_LOAD
}

struct Args { const float* in[30]; float* out; unsigned char* ws; int ph_lo, ph_hi; };
__global__ void __launch_bounds__(NWAVES * 64, 2) mk_fwd(Args args) {
    extern __shared__ __attribute__((aligned(16))) unsigned char lds[];
    Frame F;
    F.lds = (LAS unsigned char*)lds;
    F.MISC = (volatile LAS unsigned*)(F.lds + MISC_OFF);
    F.tid = threadIdx.x; F.lane = F.tid & 63; F.wave = __builtin_amdgcn_readfirstlane(F.tid >> 6);
    F.G = gridDim.x; { const int bx = blockIdx.x; F.vcu = (F.G % 8 == 0) ? (bx % 8) * (F.G / 8) + bx / 8 : bx; }
    F.ws = args.ws; F.ctl = (gu32*)(args.ws + WS_CTL); F.out = args.out;
    F.karg = (const __attribute__((address_space(4))) char*)__builtin_amdgcn_kernarg_segment_ptr();
    for (int u = F.tid; u < (LDS_BYTES - LDSCTL_OFF) / 4; u += NWAVES * 64) ((LAS unsigned*)(F.lds + LDSCTL_OFF))[u] = 0u;
    __syncthreads();
    XcdBarrier bar; bar.bar = (unsigned*)(F.ctl + CW_BAR); bar.x = 0; bar.st = nullptr;
    if (N_LAUNCHES == 1) bar = xcd_barrier_post((unsigned*)(F.ctl + CW_BAR), F.MISC + 8);
#define GRID_BAR() do { if (N_LAUNCHES == 1) xcd_barrier(bar); } while (0)
    const int lo = args.ph_lo, hi = args.ph_hi;
#ifndef PHASE_MASK
#define PHASE_MASK 0x3ff
#endif
#define IN(k) ((((PHASE_MASK) >> (k)) & 1) && lo <= (k) && (k) < hi)
#define BOTH(k) (IN(k) && IN((k) + 1))
    using namespace pg8;
    PG8_LAS unsigned char* ring = F.lds + RING_OFF;
    bf16* const W_IN = (bf16*)(F.ws + WS_WIN); bf16* const W_PA = (bf16*)(F.ws + WS_WPA); bf16* const W_PB = (bf16*)(F.ws + WS_WPB); bf16* const W_OUT = (bf16*)(F.ws + WS_WOUT);
    bf16* const W_UP = (bf16*)(F.ws + WS_WUP); bf16* const W_DN = (bf16*)(F.ws + WS_WDN);

#ifdef NO_CONV
#define P3_CONV(F, u)
#else
#define P3_CONV(F, u) p3_conv_unit(F, u)
#endif
#ifdef NO_MIX
#define P3_MIX(F, u)
#else
#define P3_MIX(F, u) p3_mix_unit(F, u)
#endif
#ifndef REPEAT_MASK
#define REPEAT_MASK 0
#endif
#define NREP(k) (1 + (((REPEAT_MASK) >> (k)) & 1))
#define PHASE(k, ...) if (IN(k)) { { int l_ = (int)__builtin_amdgcn_mbcnt_hi(~0u, __builtin_amdgcn_mbcnt_lo(~0u, 0u)); asm volatile("" : "+v"(l_)); F.lane = l_; F.tid = F.wave * 64 + l_; }     \
    for (int rep_ = 0; rep_ < NREP(k); ++rep_) { __VA_ARGS__ if (rep_ + 1 < NREP(k)) GRID_BAR(); } if (BOTH(k)) GRID_BAR(); }
    PHASE(0, p0_prologue(F);)
    PHASE(1, p1_lnmod(F);)
    PHASE(2,
        DenseOrder S; S.init(F.ws + WS_H, W_IN, T, IN_DIM, D, F.G, (int)blockIdx.x);
        EpiG1 E{(bf16*)(F.ws + WS_Z), (bf16*)(F.ws + WS_GU), (size_t)(UB / 2), (const float*)(F.ws + WS_BINP), F.lds + EVEC_OFF};
        gemm_phase<EpiG1, DenseOrder, PG8_ALIGN, true>(ring, D, S, E, F.tid);)
    PHASE(3,
        for (int u = blockIdx.x; u < T / 128; u += F.G) {
            const int sel = (blockIdx.x >> 3) & 1;
            _Pragma("unroll 1") for (int pass = 0; pass < 2; ++pass) {
                { int l_ = (int)__builtin_amdgcn_mbcnt_hi(~0u, __builtin_amdgcn_mbcnt_lo(~0u, 0u)); asm volatile("" : "+v"(l_)); F.lane = l_; F.tid = F.wave * 64 + l_; }
                if ((pass ^ sel) == 0) { P3_CONV(F, u); } else { P3_MIX(F, u); } } })
    PHASE(4,
        { DenseOrder S; S.init(F.ws + WS_AACT, W_PA, T, D, D, F.G, (int)blockIdx.x);
          EpiGate<0> E{(bf16*)(F.ws + WS_M1), (unsigned char*)(F.ws + WS_MERGED), (const unsigned char*)(F.ws + WS_SGA), INP(I_BPA), F.lds + EVEC_OFF};
          gemm_phase<EpiGate<0>, DenseOrder, PG8_ALIGN, true>(ring, D, S, E, F.tid); }
        { DenseOrder S; S.init(F.ws + WS_GATED, W_PB, T, D, D, F.G, (int)blockIdx.x);
          EpiGate<1> E{(bf16*)(F.ws + WS_M1), (unsigned char*)(F.ws + WS_MERGED), (const unsigned char*)(F.ws + WS_SGB), INP(I_BPB), F.lds + EVEC_OFF};
          gemm_phase<EpiGate<1>, DenseOrder, PG8_ALIGN, true>(ring, D, S, E, F.tid); })
    PHASE(5,
        DenseOrder S; S.init(F.ws + WS_MERGED, W_OUT, T, D, D, F.G, (int)blockIdx.x);
        EpiYO E{(unsigned char*)(F.ws + WS_YO), INP(I_BOUT), (const float*)(F.ws + WS_MOD) + MOD_GATE1, F.lds + EVEC_OFF};
        gemm_phase<EpiYO, DenseOrder, PG8_ALIGN, true>(ring, D, S, E, F.tid);)
    PHASE(6, p6_router(F);)
    PHASE(7,
        moe_tables(F);
        GroupedOrder<true> S{(const PG8_LAS int*)(F.lds + TBL_TPU), (const PG8_LAS int*)(F.lds + TBL_RS), (const PG8_LAS int*)(F.lds + TBL_CNT), 8, F.G, (int)blockIdx.x,
                       (const char*)(F.ws + WS_H2), (const char*)W_UP, (size_t)D, (size_t)BM * D, (size_t)2048 * D, (const int*)(F.ws + WS_LIST), (PG8_LAS unsigned*)(F.lds + GTAB_OFF)};
        EpiSwiglu E{(unsigned char*)(F.ws + WS_ACT), (const float*)(F.ws + WS_BUPP), F.lds + EVEC_OFF};
        gemm_phase<EpiSwiglu, GroupedOrder<true>, PG8_ALIGN, true>(ring, D, S, E, F.tid);)
    PHASE(8,
        if (!IN(7)) moe_tables(F);
        GroupedOrder<false> S{(const PG8_LAS int*)(F.lds + TBL_TPD), (const PG8_LAS int*)(F.lds + TBL_RS), (const PG8_LAS int*)(F.lds + TBL_CNT), 4, F.G, (int)blockIdx.x,
                       (const char*)(F.ws + WS_ACT), (const char*)W_DN, (size_t)D, (size_t)BM * D, (size_t)D * D, nullptr, nullptr};
        EpiDown E{(unsigned char*)(F.ws + WS_Y), INP(I_BDN), F.lds + STG_OFF, F.lds + EVEC_OFF};
        gemm_phase<EpiDown, GroupedOrder<false>, PG8_ALIGN, true>(ring, D, S, E, F.tid);)
    PHASE(9,
        if (!IN(7)) moe_tables(F);
        p10_combine(F);)
#undef PHASE
#undef NREP
#undef IN
#undef BOTH
#undef GRID_BAR
}

extern "C" void kernel_launch(void* const* d_in, const int* in_sizes, int n_in, void* d_out, int out_size, void* d_ws, size_t ws_size, hipStream_t stream) {
    static int grid = 0;
    if (grid == 0) {
        if (n_in != 30 || in_sizes[0] != T * D || out_size != T * D || ws_size < WS_END) { fprintf(stderr, "kernel_launch: unexpected shapes (n_in %d, in0 %d, out %d, ws %zu); nothing launched\n", n_in, n_in > 0 ? in_sizes[0] : -1, out_size, ws_size); grid = -1; return; }
        int dev = 0, cus = 0, per_cu = 0;
        if (hipGetDevice(&dev) != hipSuccess || hipDeviceGetAttribute(&cus, hipDeviceAttributeMultiprocessorCount, dev) != hipSuccess) { fprintf(stderr, "kernel_launch: device query failed\n"); grid = -1; return; }
        if (hipFuncSetAttribute((const void*)mk_fwd, hipFuncAttributeMaxDynamicSharedMemorySize, LDS_BYTES) != hipSuccess) { fprintf(stderr, "kernel_launch: hipFuncSetAttribute failed\n"); grid = -1; return; }
        if (hipOccupancyMaxActiveBlocksPerMultiprocessor(&per_cu, (const void*)mk_fwd, NWAVES * 64, LDS_BYTES) != hipSuccess || per_cu < 1) { fprintf(stderr, "kernel_launch: occupancy query reports %d workgroups per CU\n", per_cu); per_cu = 1; }
        (void)hipGetLastError();
        grid = cus;
    }
    if (grid < 0) return;
    if (hipMemsetAsync((char*)d_ws + WS_CTL, 0, CTL_ZERO_BYTES, stream) != hipSuccess) { fprintf(stderr, "kernel_launch: hipMemsetAsync failed\n"); return; }
    Args a{};
    for (int i = 0; i < 30; ++i) a.in[i] = (const float*)d_in[i];
    a.out = (float*)d_out; a.ws = (unsigned char*)d_ws;
    if (N_LAUNCHES == 1) {
        a.ph_lo = 0; a.ph_hi = NPH;
        void* kargs[] = {&a};
        hipError_t le = hipLaunchCooperativeKernel((const void*)mk_fwd, dim3(grid), dim3(NWAVES * 64), kargs, LDS_BYTES, stream);
        if (le != hipSuccess) { (void)hipGetLastError(); fprintf(stderr, "kernel_launch: cooperative launch failed (%s), plain launch instead\n", hipGetErrorName(le)); hipLaunchKernelGGL(mk_fwd, dim3(grid), dim3(NWAVES * 64), LDS_BYTES, stream, a); }
    } else {
        for (int li = 0; li < NPH; ++li) for (int rp = 0; rp < 1 + ((HOST_REPEAT >> li) & 1); ++rp) { a.ph_lo = li; a.ph_hi = li + 1; hipLaunchKernelGGL(mk_fwd, dim3(grid), dim3(NWAVES * 64), LDS_BYTES, stream, a); }
    }
}
```

```cpp
#include <hip/hip_runtime.h>
#include <cstdio>
#include <cstdint>

#ifndef MK_N_LAUNCHES
#define MK_N_LAUNCHES 1
#endif
#ifndef HOST_REPEAT
#define HOST_REPEAT 0
#endif

namespace pg8 {
#define PG8_LAS __attribute__((address_space(3)))
typedef unsigned short bf16_t;
typedef short bf16x8 __attribute__((ext_vector_type(8)));
typedef float f32x4 __attribute__((ext_vector_type(4)));
typedef float f32x2 __attribute__((ext_vector_type(2)));
typedef unsigned u32x4 __attribute__((ext_vector_type(4)));
typedef unsigned u32x2 __attribute__((ext_vector_type(2)));
constexpr int BM = 256, BK = 64, HALF = 128, HTB = HALF * BK * 2  , STAGE_BYTES = 8 * HTB, NXCD = 8, WGM = 8;

__host__ __device__ __forceinline__ int lds_off(int R, int c) { return (R >> 3) * 1024 + (c >> 2) * 512 + (R & 7) * 64 + (((c & 3) ^ (((R >> 3) & 1) << 1)) * 16); }
__host__ __device__ __forceinline__ int perm32(int rho) { const int n = rho >> 4, i = rho & 15; return 8 * (i >> 2) + 4 * n + (i & 3); }

struct Unit { int pn; int row0; int e; int nvalid; int l0; };

struct DenseOrder {
    static constexpr bool GATHER = false;
    __device__ __forceinline__ PG8_LAS unsigned* gtab() const { return nullptr; }
    __device__ __forceinline__ unsigned rowoff(const Unit&, int) const { return 0u; }
    int nM, nN, nwg, G, c; const char* A; const char* Bt; size_t rowbytes, tstep;
    unsigned* ready_in = nullptr; unsigned* ready_out = nullptr; unsigned need = 0u;
    __device__ __forceinline__ void init(const void* A_, const void* Bt_, int M, int N, int rowbytes_, int G_, int c_) { nM = M / BM; nN = N / BM; nwg = nM * nN; G = G_; c = c_; A = (const char*)A_; Bt = (const char*)Bt_; rowbytes = (size_t)rowbytes_; tstep = (size_t)BM * rowbytes_; }
    __device__ __forceinline__ bool next(int i, Unit& u) const {
        const long L = (long)i * G + c; if (L >= nwg) return false;
        int wgid = (int)L; { const int q = nwg / NXCD, r = nwg % NXCD, xcd = wgid % NXCD, off = wgid / NXCD; wgid = (xcd < r ? xcd * (q + 1) : r * (q + 1) + (xcd - r) * q) + off; }
        const int nig = WGM * nN, gid = wgid / nig, fm = gid * WGM, gsz = (nM - fm) < WGM ? (nM - fm) : WGM;
        const int pm = fm + ((wgid % nig) % gsz); u.pn = (wgid % nig) / gsz; u.row0 = pm * BM; u.e = 0; u.nvalid = BM; u.l0 = pm; return true;
    }
    __device__ __forceinline__ const char* abase(const Unit& u) const { return A + (size_t)u.row0 * rowbytes; }
    __device__ __forceinline__ const char* bbase(const Unit& u) const { return Bt + (size_t)u.pn * tstep; }
    __device__ __forceinline__ void a_ready(const Unit& u) const { if (need) { unsigned* w = ready_in + u.l0; unsigned sp = 0u;
        while (__hip_atomic_load(w, __ATOMIC_RELAXED, __HIP_MEMORY_SCOPE_AGENT) < need && ++sp < (1u << 22)) __builtin_amdgcn_s_sleep(2); asm volatile("" ::: "memory"); } }
    __device__ __forceinline__ void done(const Unit&) const {}
    __device__ __forceinline__ void signal(int, int l0) const { if (ready_out != nullptr && threadIdx.x == 0) (void)__hip_atomic_fetch_add(ready_out + l0, 1u, __ATOMIC_RELAXED, __HIP_MEMORY_SCOPE_AGENT); }
};
template <bool GATHER_> struct GroupedOrder {
    static constexpr bool GATHER = GATHER_; static constexpr int LSTRIDE = 32768;
    const PG8_LAS int* tp; const PG8_LAS int* rs; const PG8_LAS int* cnt; int npn, base, stride, nun; unsigned* ready; const char* A; const char* Bt; size_t rowbytes, tstep, estride; const int* list; PG8_LAS unsigned* gt;
    __device__ __forceinline__ bool next(int i, Unit& u) const {
        if (i >= nun) return false; const int L = base + i * stride;
        int e = 0;
#pragma unroll
        for (int st_ = 16; st_ >= 1; st_ >>= 1) { const int c_ = e + st_; if (L >= __builtin_amdgcn_readfirstlane(tp[c_ < 32 ? c_ : 32])) e = c_ < 32 ? c_ : e; }
        e = __builtin_amdgcn_readfirstlane(e);
        const int local = L - __builtin_amdgcn_readfirstlane(tp[e]); const int mt = local / npn; u.pn = __builtin_amdgcn_readfirstlane(local - mt * npn); u.e = e; u.l0 = __builtin_amdgcn_readfirstlane(e * LSTRIDE + BM * mt);
        u.row0 = __builtin_amdgcn_readfirstlane(__builtin_amdgcn_readfirstlane(rs[e]) + BM * mt); const int left = __builtin_amdgcn_readfirstlane(cnt[e]) - BM * mt; u.nvalid = __builtin_amdgcn_readfirstlane(left < BM ? left : BM); return true;
    }
    __device__ __forceinline__ const char* abase(const Unit& u) const { return GATHER ? A : A + (size_t)u.row0 * rowbytes; }
    __device__ __forceinline__ const char* bbase(const Unit& u) const { return Bt + (size_t)u.e * estride + (size_t)u.pn * tstep; }
    __device__ __forceinline__ PG8_LAS unsigned* gtab() const { return gt; }
    __device__ __forceinline__ unsigned rowoff(const Unit& u, int rowl) const { const int r = rowl < u.nvalid ? rowl : 0; return ((unsigned)list[u.l0 + r] & (unsigned)(LSTRIDE - 1)) * (unsigned)rowbytes; }
    __device__ __forceinline__ int rowtile(const Unit& u) const { return __builtin_amdgcn_readfirstlane(tp[u.e]) / npn + ((u.l0 & (LSTRIDE - 1)) >> 8); }
    __device__ __forceinline__ void a_ready(const Unit& u) const { if constexpr (!GATHER) { unsigned* w = ready + rowtile(u); unsigned sp = 0u;
        while (__hip_atomic_load(w, __ATOMIC_RELAXED, __HIP_MEMORY_SCOPE_AGENT) < 8u && ++sp < (1u << 22)) __builtin_amdgcn_s_sleep(2); asm volatile("" ::: "memory"); } }
    __device__ __forceinline__ void signal(int e, int l0) const { if constexpr (GATHER) { if (threadIdx.x == 0) (void)__hip_atomic_fetch_add(ready + (__builtin_amdgcn_readfirstlane(tp[e]) / npn + ((l0 & (LSTRIDE - 1)) >> 8)), 1u, __ATOMIC_RELAXED, __HIP_MEMORY_SCOPE_AGENT); } }
    __device__ __forceinline__ void done(const Unit&) const {}
};

__device__ __forceinline__ unsigned cvt_pk_bf16(float lo, float hi) { unsigned r; asm volatile("v_cvt_pk_bf16_f32 %0, %1, %2" : "=v"(r) : "v"(lo), "v"(hi)); return r; }
__device__ __forceinline__ unsigned pk4_fp8_raw(float a, float b, float c, float d) { int p = __builtin_amdgcn_cvt_pk_fp8_f32(a, b, 0, false); p = __builtin_amdgcn_cvt_pk_fp8_f32(c, d, p, true); return (unsigned)p; }
__device__ __forceinline__ float sat8(float v) { return __builtin_amdgcn_fmed3f(v, -448.0f, 448.0f); }
__device__ __forceinline__ unsigned pk4_fp8(float a, float b, float c, float d) { int p = __builtin_amdgcn_cvt_pk_fp8_f32(sat8(a), sat8(b), 0, false); p = __builtin_amdgcn_cvt_pk_fp8_f32(sat8(c), sat8(d), p, true); return (unsigned)p; }
constexpr float W8_SCALE = 32.0f, ACT8_SCALE = 4.0f, G8_SCALE = 128.0f, YO8_SCALE = 64.0f;
__device__ __forceinline__ float bf_lo(unsigned w) { return __uint_as_float(w << 16); }
__device__ __forceinline__ float bf_hi(unsigned w) { return __uint_as_float(w & 0xffff0000u); }
__device__ __forceinline__ f32x2 gelu_pk(f32x2 v) {
    const f32x2 av = __builtin_elementwise_abs(v), d = av * 0.2316418882f + 1.0f;
    f32x2 t; t.x = __builtin_amdgcn_rcpf(d.x); t.y = __builtin_amdgcn_rcpf(d.y);
    f32x2 q = t * 0.5307027145f + (-0.7265760135f); q = q * t + 0.7107068705f; q = q * t + (-0.142248368f); q = q * t + 0.127414796f; q = q * t;
    const f32x2 s = (v * v) * (-0.72134752044f);
    f32x2 e; e.x = __builtin_amdgcn_exp2f(s.x); e.y = __builtin_amdgcn_exp2f(s.y);
    const f32x2 m = v * (q * e), r = v - m;
    f32x2 o; o.x = v.x < 0.f ? m.x : r.x; o.y = v.y < 0.f ? m.y : r.y; return o;
}
__device__ __forceinline__ f32x4 gelu4(f32x4 v) { const f32x2 a = gelu_pk((f32x2){v[0], v[1]}), b = gelu_pk((f32x2){v[2], v[3]}); return (f32x4){a.x, a.y, b.x, b.y}; }
__device__ __forceinline__ float sigm(float x) { return __builtin_amdgcn_rcpf(1.0f + __builtin_amdgcn_exp2f(-1.44269504089f * x)); }
__device__ __forceinline__ f32x4 sigm4(f32x4 v) { const f32x4 t = v * (-1.44269504089f); const f32x4 d = (f32x4){__builtin_amdgcn_exp2f(t[0]), __builtin_amdgcn_exp2f(t[1]), __builtin_amdgcn_exp2f(t[2]), __builtin_amdgcn_exp2f(t[3])} + 1.0f;
    return (f32x4){__builtin_amdgcn_rcpf(d[0]), __builtin_amdgcn_rcpf(d[1]), __builtin_amdgcn_rcpf(d[2]), __builtin_amdgcn_rcpf(d[3])}; }
__device__ __forceinline__ u32x4 pack8(f32x4 v0, f32x4 v1) { u32x4 w; w.x = cvt_pk_bf16(v0[0], v0[1]); w.y = cvt_pk_bf16(v0[2], v0[3]); w.z = cvt_pk_bf16(v1[0], v1[1]); w.w = cvt_pk_bf16(v1[2], v1[3]); return w; }
__device__ __forceinline__ void unpack8(u32x4 w, f32x4& v0, f32x4& v1) { v0 = (f32x4){bf_lo(w.x), bf_hi(w.x), bf_lo(w.y), bf_hi(w.y)}; v1 = (f32x4){bf_lo(w.z), bf_hi(w.z), bf_lo(w.w), bf_hi(w.w)}; }

constexpr int LDC = 1024;

template <int ROWB, int NP> struct Stage {
    static constexpr int PITCH = ROWB + 16;
    PG8_LAS unsigned char* base;
    __device__ __forceinline__ void put16(int p, int rho, int bytecol, u32x4 v) const { *(PG8_LAS u32x4*)(base + (p * 32 + rho) * PITCH + bytecol) = v; }
    __device__ __forceinline__ void put8(int p, int rho, int bytecol, u32x2 v) const { *(PG8_LAS u32x2*)(base + (p * 32 + rho) * PITCH + bytecol) = v; }
    __device__ __forceinline__ void flush(int tid, unsigned char* dst, size_t pitch, int ai, int m0, int nvalid) const {
        asm volatile("s_waitcnt lgkmcnt(0)" ::: "memory"); __builtin_amdgcn_s_barrier(); asm volatile("" ::: "memory");
        constexpr int CPR = ROWB / 16, NCH = 32 * NP * CPR; static_assert(NCH == 1024, "two 16-byte chunks per thread");
#pragma unroll
        for (int i = 0; i < 2; ++i) { const int q = tid + 512 * i, sg = q / CPR, c = q % CPR, p = sg >> 5, rho = sg & 31, trow = 128 * ai + 64 * (rho >> 4) + 16 * (m0 + p) + (rho & 15);
            const u32x4 v = *(const PG8_LAS u32x4*)(base + sg * PITCH + 16 * c);
            if (trow < nvalid) __builtin_nontemporal_store(v, (u32x4*)(dst + (size_t)trow * pitch + 16 * c)); }
        asm volatile("s_waitcnt lgkmcnt(0)" ::: "memory"); __builtin_amdgcn_s_barrier(); asm volatile("" ::: "memory");
    }
};

__device__ __forceinline__ u32x4 widen8(u32x2 wa, u32x2 wb) { const auto rx = __builtin_amdgcn_permlane16_swap(wa.x, wb.x, false, false); const auto ry = __builtin_amdgcn_permlane16_swap(wa.y, wb.y, false, false); return (u32x4){rx[0], ry[0], rx[1], ry[1]}; }
struct EpiG1 {
    static constexpr bool PERM = true, AFTER_DRAIN = false;
    static constexpr int NVEC = 1;
    bf16_t *Z, *GU; size_t tstride; const float* bias; PG8_LAS unsigned char* evl;
    __device__ __forceinline__ const float* evec(const Unit& u, int) const { return bias + u.pn * BM; }
    __device__ __forceinline__ void operator()(const f32x4 (&acc)[2][2][4][2], const Unit& u, int wr, int wc, int fr, int fq, int tid, const PG8_LAS float* ev) const {
        const int row0 = u.row0 + wr * 64 + fr;
        f32x4 bv[2][2];
#pragma unroll
        for (int bj = 0; bj < 2; ++bj)
#pragma unroll
            for (int n = 0; n < 2; ++n) bv[bj][n] = *(const PG8_LAS f32x4*)(ev + wc * 32 + 8 * fq + bj * HALF + 4 * n);
        if (u.pn < 8) {
            const int col0 = u.pn * HALF + wc * 32 + 8 * fq;
#pragma unroll
            for (int ai = 0; ai < 2; ++ai)
#pragma unroll
                for (int m = 0; m < 4; ++m) { bf16_t* rowp = Z + (size_t)(row0 + ai * HALF + m * 16) * LDC + col0;
                    const f32x4 v0 = acc[ai][0][m][0] * (1.0f / W8_SCALE) + bv[0][0], v1 = acc[ai][0][m][1] * (1.0f / W8_SCALE) + bv[0][1], g0 = acc[ai][1][m][0] * (1.0f / W8_SCALE) + bv[1][0], g1 = acc[ai][1][m][1] * (1.0f / W8_SCALE) + bv[1][1];
                    *(u32x4*)rowp = pack8(v0 * sigm4(g0), v1 * sigm4(g1)); }
        } else {
            const int t = (u.pn - 8) >> 2; bf16_t* base = GU + (size_t)t * tstride; u32x2 sgw[2][2];
            const int col0 = ((u.pn - 8) & 3) * BM + wc * 32 + 8 * fq;
#pragma unroll
            for (int ai = 0; ai < 2; ++ai)
#pragma unroll
                for (int m = 0; m < 4; ++m) { bf16_t* rowp = base + (size_t)(row0 + ai * HALF + m * 16) * LDC + col0;
#pragma unroll
                    for (int bj = 0; bj < 2; ++bj) { f32x4 v0 = acc[ai][bj][m][0] * (1.0f / W8_SCALE) + bv[bj][0], v1 = acc[ai][bj][m][1] * (1.0f / W8_SCALE) + bv[bj][1];
                        if (t < 2) { v0 = gelu4(v0); v1 = gelu4(v1); *(u32x4*)(rowp + bj * HALF) = pack8(v0, v1); }
                        else { v0 = sigm4(v0) * G8_SCALE; v1 = sigm4(v1) * G8_SCALE; sgw[m & 1][bj].x = pk4_fp8_raw(v0[0], v0[1], v0[2], v0[3]); sgw[m & 1][bj].y = pk4_fp8_raw(v1[0], v1[1], v1[2], v1[3]);
                            if (m & 1) { const int od = fq & 1; *(u32x4*)((unsigned char*)base + (size_t)(row0 + ai * HALF + (m - 1 + od) * 16) * LDC + col0 + bj * HALF - 8 * od) = widen8(sgw[0][bj], sgw[1][bj]); } } } }
        }
    }
};
constexpr float M8_SCALE = 16.0f;
template <int MODE> struct EpiGate {
    static constexpr bool PERM = true, AFTER_DRAIN = false;
    static constexpr int NVEC = 1;
    bf16_t* M1; unsigned char* MG8; const unsigned char* Gt; const float* bias; PG8_LAS unsigned char* evl;
    __device__ __forceinline__ const float* evec(const Unit& u, int) const { return bias + u.pn * BM; }
    __device__ __forceinline__ void operator()(const f32x4 (&acc)[2][2][4][2], const Unit& u, int wr, int wc, int fr, int fq, int tid, const PG8_LAS float* ev) const {
        const int row0 = u.row0 + wr * 64 + fr, col0 = u.pn * BM + wc * 32 + 8 * fq;
        f32x4 bv[2][2];
#pragma unroll
        for (int bj = 0; bj < 2; ++bj)
#pragma unroll
            for (int n = 0; n < 2; ++n) bv[bj][n] = *(const PG8_LAS f32x4*)(ev + wc * 32 + 8 * fq + bj * HALF + 4 * n);
#pragma unroll
        for (int ai = 0; ai < 2; ++ai) {
            u32x2 gq[4][2]; u32x2 oq[4][2];
#pragma unroll
            for (int m = 0; m < 4; ++m)
#pragma unroll
                for (int bj = 0; bj < 2; ++bj) { const size_t off = (size_t)(row0 + ai * HALF + m * 16) * LDC + col0 + bj * HALF; gq[m][bj] = *(const u32x2*)(Gt + off); if (MODE == 1) oq[m][bj] = *(const u32x2*)((const unsigned char*)M1 + off); }
            asm volatile("" ::: "memory");
#pragma unroll
            for (int mp = 0; mp < 4; mp += 2)
#pragma unroll
                for (int bj = 0; bj < 2; ++bj) { u32x2 w2[2];
#pragma unroll
                    for (int mm = 0; mm < 2; ++mm) { const int m = mp + mm; const size_t off = (size_t)(row0 + ai * HALF + m * 16) * LDC + col0 + bj * HALF;
                        const f32x2 ga = __builtin_amdgcn_cvt_pk_f32_fp8((int)gq[m][bj].x, false), gb = __builtin_amdgcn_cvt_pk_f32_fp8((int)gq[m][bj].x, true), gc = __builtin_amdgcn_cvt_pk_f32_fp8((int)gq[m][bj].y, false), gd = __builtin_amdgcn_cvt_pk_f32_fp8((int)gq[m][bj].y, true);
                        const f32x4 g0 = {ga.x, ga.y, gb.x, gb.y}, g1 = {gc.x, gc.y, gd.x, gd.y};
                        f32x4 v0 = (acc[ai][bj][m][0] * (1.0f / (W8_SCALE * G8_SCALE)) + bv[bj][0] * (1.0f / G8_SCALE)) * g0, v1 = (acc[ai][bj][m][1] * (1.0f / (W8_SCALE * G8_SCALE)) + bv[bj][1] * (1.0f / G8_SCALE)) * g1;
                        if (MODE == 1) { const f32x2 oa = __builtin_amdgcn_cvt_pk_f32_fp8((int)oq[m][bj].x, false), ob = __builtin_amdgcn_cvt_pk_f32_fp8((int)oq[m][bj].x, true), oc = __builtin_amdgcn_cvt_pk_f32_fp8((int)oq[m][bj].y, false), od_ = __builtin_amdgcn_cvt_pk_f32_fp8((int)oq[m][bj].y, true);
                            v0 += (f32x4){oa.x, oa.y, ob.x, ob.y} * (1.0f / M8_SCALE); v1 += (f32x4){oc.x, oc.y, od_.x, od_.y} * (1.0f / M8_SCALE); }
                        else { v0 = v0 * M8_SCALE; v1 = v1 * M8_SCALE; }
                        w2[mm].x = pk4_fp8(v0[0], v0[1], v0[2], v0[3]); w2[mm].y = pk4_fp8(v1[0], v1[1], v1[2], v1[3]); }
                    { const int od = fq & 1; *(u32x4*)((MODE == 1 ? MG8 : (unsigned char*)M1) + (size_t)(row0 + ai * HALF + (mp + od) * 16) * LDC + col0 + bj * HALF - 8 * od) = widen8(w2[0], w2[1]); } }
        }
    }
};
struct EpiYO {
    static constexpr bool PERM = true, AFTER_DRAIN = false;
    static constexpr int NVEC = 2;
    unsigned char* YO; const float* bias; const float* gate; PG8_LAS unsigned char* evl;
    __device__ __forceinline__ const float* evec(const Unit& u, int v) const { return v == 0 ? bias + u.pn * BM : gate + (size_t)(u.row0 >> 12) * 6144 + u.pn * BM; }
    __device__ __forceinline__ void operator()(const f32x4 (&acc)[2][2][4][2], const Unit& u, int wr, int wc, int fr, int fq, int tid, const PG8_LAS float* ev) const {
        const int row0 = u.row0 + wr * 64 + fr, col0 = u.pn * BM + wc * 32 + 8 * fq;
        f32x4 bv[2][2], gv[2][2];
#pragma unroll
        for (int bj = 0; bj < 2; ++bj)
#pragma unroll
            for (int n = 0; n < 2; ++n) { bv[bj][n] = *(const PG8_LAS f32x4*)(ev + wc * 32 + 8 * fq + bj * HALF + 4 * n); gv[bj][n] = *(const PG8_LAS f32x4*)(ev + 256 + wc * 32 + 8 * fq + bj * HALF + 4 * n); }
#pragma unroll
        for (int ai = 0; ai < 2; ++ai)
#pragma unroll
            for (int mp = 0; mp < 4; mp += 2) { const int od = fq & 1; unsigned char* rowp = YO + (size_t)(row0 + ai * HALF + (mp + od) * 16) * LDC + col0 - 8 * od;
#pragma unroll
                for (int bj = 0; bj < 2; ++bj) { u32x2 w2[2];
#pragma unroll
                    for (int mm = 0; mm < 2; ++mm) { const int m = mp + mm; const f32x4 v0 = gv[bj][0] * (acc[ai][bj][m][0] * (YO8_SCALE / W8_SCALE) + bv[bj][0] * YO8_SCALE), v1 = gv[bj][1] * (acc[ai][bj][m][1] * (YO8_SCALE / W8_SCALE) + bv[bj][1] * YO8_SCALE);
                        w2[mm].x = pk4_fp8(v0[0], v0[1], v0[2], v0[3]); w2[mm].y = pk4_fp8(v1[0], v1[1], v1[2], v1[3]); }
                    *(u32x4*)(rowp + bj * HALF) = widen8(w2[0], w2[1]); } }
    }
};
struct EpiSwiglu {
    static constexpr bool PERM = true, AFTER_DRAIN = false;
    static constexpr int NVEC = 1;
    unsigned char* ACT; const float* bias; PG8_LAS unsigned char* evl;
    __device__ __forceinline__ const float* evec(const Unit& u, int) const { return bias + (size_t)u.e * 2048 + u.pn * BM; }
    __device__ __forceinline__ void operator()(const f32x4 (&acc)[2][2][4][2], const Unit& u, int wr, int wc, int fr, int fq, int tid, const PG8_LAS float* ev) const {
        const int rl0 = wr * 64 + fr, col0 = u.pn * HALF + wc * 32 + 8 * fq;
        f32x4 bv[2][2];
#pragma unroll
        for (int bj = 0; bj < 2; ++bj)
#pragma unroll
            for (int n = 0; n < 2; ++n) bv[bj][n] = *(const PG8_LAS f32x4*)(ev + wc * 32 + 8 * fq + bj * HALF + 4 * n);
#pragma unroll
        for (int ai = 0; ai < 2; ++ai)
#pragma unroll
            for (int mp = 0; mp < 4; mp += 2) { u32x2 w2[2];
#pragma unroll
                for (int mm = 0; mm < 2; ++mm) { const int m = mp + mm;
                    f32x4 o[2];
#pragma unroll
                    for (int n = 0; n < 2; ++n) {
                        const f32x4 gl = acc[ai][0][m][n] * (1.0f / W8_SCALE) + bv[0][n], li = acc[ai][1][m][n] * (1.0f / W8_SCALE) + bv[1][n];
                        const f32x4 g = __builtin_elementwise_min(gl, (f32x4){7.0f, 7.0f, 7.0f, 7.0f});
                        const f32x4 l4 = (f32x4){__builtin_amdgcn_fmed3f(li[0], -7.0f, 7.0f), __builtin_amdgcn_fmed3f(li[1], -7.0f, 7.0f), __builtin_amdgcn_fmed3f(li[2], -7.0f, 7.0f), __builtin_amdgcn_fmed3f(li[3], -7.0f, 7.0f)} * ACT8_SCALE + ACT8_SCALE;
                        const f32x4 t = g * (-1.702f * 1.44269504089f);
                        const f32x4 d = (f32x4){__builtin_amdgcn_exp2f(t[0]), __builtin_amdgcn_exp2f(t[1]), __builtin_amdgcn_exp2f(t[2]), __builtin_amdgcn_exp2f(t[3])} + 1.0f;
                        const f32x4 r = {__builtin_amdgcn_rcpf(d[0]), __builtin_amdgcn_rcpf(d[1]), __builtin_amdgcn_rcpf(d[2]), __builtin_amdgcn_rcpf(d[3])};
                        o[n] = (g * r) * l4; }
                    w2[mm].x = pk4_fp8_raw(o[0][0], o[0][1], o[0][2], o[0][3]); w2[mm].y = pk4_fp8_raw(o[1][0], o[1][1], o[1][2], o[1][3]); }
                const u32x4 w4 = widen8(w2[0], w2[1]); const int od = fq & 1, rl = rl0 + ai * HALF + (mp + od) * 16;
                if (rl < u.nvalid) *(u32x4*)(ACT + (size_t)(u.row0 + rl) * LDC + col0 - 8 * od) = w4; }
    }
};
constexpr float Y8_SCALE = 16.0f;
struct EpiDown {
    static constexpr bool PERM = true, AFTER_DRAIN = false;
    static constexpr int NVEC = 1;
    unsigned char* Y8; const float* bias; PG8_LAS unsigned char* stg; PG8_LAS unsigned char* evl;
    __device__ __forceinline__ const float* evec(const Unit& u, int) const { return bias + (size_t)u.e * 1024 + u.pn * BM; }
    __device__ __forceinline__ void operator()(const f32x4 (&acc)[2][2][4][2], const Unit& u, int wr, int wc, int fr, int fq, int tid, const PG8_LAS float* ev) const {
        f32x4 bv[2][2];
#pragma unroll
        for (int bj = 0; bj < 2; ++bj)
#pragma unroll
            for (int n = 0; n < 2; ++n) bv[bj][n] = *(const PG8_LAS f32x4*)(ev + wc * 32 + 8 * fq + bj * HALF + 4 * n) * Y8_SCALE;
        const Stage<256, 2> st{stg}; unsigned char* dst = Y8 + (size_t)u.row0 * LDC + u.pn * BM;
#pragma unroll
        for (int ai = 0; ai < 2; ++ai)
#pragma unroll
            for (int m = 0; m < 4; ++m) {
#pragma unroll
                for (int bj = 0; bj < 2; ++bj) { const f32x4 v0 = acc[ai][bj][m][0] * (Y8_SCALE / (W8_SCALE * ACT8_SCALE)) + bv[bj][0], v1 = acc[ai][bj][m][1] * (Y8_SCALE / (W8_SCALE * ACT8_SCALE)) + bv[bj][1];
                    u32x2 w; w.x = pk4_fp8(v0[0], v0[1], v0[2], v0[3]); w.y = pk4_fp8(v1[0], v1[1], v1[2], v1[3]); st.put8(m & 1, 16 * wr + fr, bj * HALF + wc * 32 + 8 * fq, w); }
                if (m & 1) st.flush(tid, dst, LDC, ai, m - 1, u.nvalid); }
    }
};

typedef int v8i __attribute__((ext_vector_type(8)));
typedef int v4i __attribute__((ext_vector_type(4)));
template <class Epi, class Sched, bool ALIGN_EPI = false, bool F8 = false>
__device__ __forceinline__ void gemm_phase(PG8_LAS unsigned char* lds, const int rowbytes, const Sched& S, const Epi& E, const int tid) {
    constexpr bool GA = Sched::GATHER;
    int lane_ = tid & 63; asm volatile("" : "+v"(lane_));
    const int wid = __builtin_amdgcn_readfirstlane(tid >> 6), lane = lane_, wr = wid >> 2, wc = wid & 3, fr = lane & 15, fq = lane >> 4;
    const int nt = rowbytes / 128;
    unsigned voffA, voffB;
    { const int R = wid * 8 + ((lane >> 2) & 7), cb = (((lane >> 5) << 2) | ((lane & 3) ^ ((wid & 1) << 1))) * 16; const int Rb = Epi::PERM ? ((R & ~31) + perm32(R & 31)) : R; voffA = GA ? (unsigned)cb : (unsigned)(R * rowbytes + cb); voffB = (unsigned)(Rb * rowbytes + cb); }
    const size_t qstep = (size_t)64 * rowbytes;
    const size_t kstep = (size_t)(BK * 2);
    const size_t hstep = (size_t)HALF * rowbytes;
    const unsigned ldsw = (unsigned)wid * 1024u, ldsbase = (unsigned)(unsigned long)lds;
    const int aoff = lds_off(wr * 64 + fr, fq); int boff = lds_off(wc * 32 + fr, fq) + 4 * HTB;
    asm volatile("" : "+v"(boff));
#define PG8_SA(b, h) (((b) * 2 + (h)) * HTB)
#define PG8_SB(b, h) ((4 + (b) * 2 + (h)) * HTB)
#define PG8_DMA(gb, lo, vo) do { unsigned keep_; asm volatile("s_mov_b32 %0, m0\n\ts_mov_b32 m0, %3\n\ts_nop 0\n\tglobal_load_lds_dwordx4 %1, %2\n\ts_mov_b32 m0, %0" : "=&s"(keep_) : "v"(vo), "s"(gb), "s"(lo) : "memory"); } while (0)
#define PG8_STAGE(bufoff, gbase, voff) do { const char* gb0_ = (const char*)(gbase); const char* gb1_ = gb0_ + qstep; const unsigned l0_ = ldsbase + (unsigned)(bufoff) + ldsw; \
        PG8_DMA(gb0_, l0_, voff); PG8_DMA(gb1_, l0_ + 8192u, voff); } while (0)
#define PG8_STAGE_A(bufoff, ap, h, slot) do { if constexpr (GA) { unsigned l_ = __builtin_amdgcn_mbcnt_hi(~0u, __builtin_amdgcn_mbcnt_lo(~0u, 0u)); asm volatile("" : "+v"(l_));     \
            const unsigned cb_ = (((l_ >> 5) << 2) | ((l_ & 3u) ^ ((unsigned)(wid & 1) << 1))) * 16u; PG8_LAS unsigned* gt_ = S.gtab() + wid * 256 + (slot) * 64 + ((l_ >> 2) & 7u) + 16 * (h); const unsigned g0_ = gt_[0] + cb_, g1_ = gt_[8] + cb_; \
            const char* gb_ = (const char*)(ap); const unsigned l0_ = ldsbase + (unsigned)(bufoff) + ldsw; PG8_DMA(gb_, l0_, g0_); PG8_DMA(gb_, l0_ + 8192u, g1_); } \
        else { PG8_STAGE(bufoff, (ap) + (h) * hstep, voffA); } } while (0)
#define PG8_GFILL(u, slot) do { if constexpr (GA) { int l_ = (int)__builtin_amdgcn_mbcnt_hi(~0u, __builtin_amdgcn_mbcnt_lo(~0u, 0u)); asm volatile("" : "+v"(l_));     \
        (S.gtab() + wid * 256)[(slot) * 64 + (l_ & 31)] = S.rowoff(u, wid * 8 + (l_ & 7) + 64 * ((l_ >> 3) & 3)); } } while (0)
#define PG8_LD16(off) (*(const PG8_LAS v4i*)(lds + (off)))
#define PG8_LDA(dst, b, h) do { _Pragma("unroll") for (int m = 0; m < 4; ++m) { const v4i lo_ = PG8_LD16(PG8_SA(b, h) + aoff + m * 2048), hi_ = PG8_LD16(PG8_SA(b, h) + aoff + m * 2048 + 512); dst[m] = __builtin_shufflevector(lo_, hi_, 0, 1, 2, 3, 4, 5, 6, 7); } } while (0)
#define PG8_LDB(dst, b, h) do { _Pragma("unroll") for (int n = 0; n < 2; ++n) { const v4i lo_ = PG8_LD16(PG8_SA(b, h) + boff + n * 2048), hi_ = PG8_LD16(PG8_SA(b, h) + boff + n * 2048 + 512); dst[n] = __builtin_shufflevector(lo_, hi_, 0, 1, 2, 3, 4, 5, 6, 7); } } while (0)
#define PG8_MMA(ai, bj, At, Bt, ZC) do { __builtin_amdgcn_s_setprio(1); _Pragma("unroll") for (int m = 0; m < 4; ++m) _Pragma("unroll") for (int n = 0; n < 2; ++n) { \
        const f32x4 c0_ = (ZC) ? (f32x4){0.f, 0.f, 0.f, 0.f} : acc[ai][bj][m][n];     \
        if constexpr (F8) acc[ai][bj][m][n] = __builtin_amdgcn_mfma_scale_f32_16x16x128_f8f6f4(Bt[n], At[m], c0_, 0, 0, 0, 0, 0, 0); \
        else { acc[ai][bj][m][n] = __builtin_amdgcn_mfma_f32_16x16x32_bf16((bf16x8)__builtin_shufflevector(Bt[n], Bt[n], 0, 1, 2, 3), (bf16x8)__builtin_shufflevector(At[m], At[m], 0, 1, 2, 3), c0_, 0, 0, 0); \
               acc[ai][bj][m][n] = __builtin_amdgcn_mfma_f32_16x16x32_bf16((bf16x8)__builtin_shufflevector(Bt[n], Bt[n], 4, 5, 6, 7), (bf16x8)__builtin_shufflevector(At[m], At[m], 4, 5, 6, 7), acc[ai][bj][m][n], 0, 0, 0); } } \
        __builtin_amdgcn_s_setprio(0); } while (0)
#define PG8_WAIT_V(n) asm volatile("s_waitcnt vmcnt(" #n ")" ::: "memory")
#define PG8_WAIT_L(n) asm volatile("s_waitcnt lgkmcnt(" #n ")" ::: "memory")
#define PG8_BAR __builtin_amdgcn_s_barrier()
#define PG8_SCHED __builtin_amdgcn_sched_barrier(0)
    Unit cur, nxt; int ui = 0;
    if (!S.next(0, cur)) return;
    Unit un1 = cur, un2 = cur; bool has1 = S.next(1, un1), has2 = false;
    if constexpr (GA) { PG8_GFILL(cur, 0); if (has1) PG8_GFILL(un1, 1); }
    f32x4 acc[2][2][4][2];
    v8i At[4], B0[2], B1[2];
    const char* cA = S.abase(cur); const char* cB = S.bbase(cur);
    S.a_ready(cur);
#define PG8_EVEC(u_, slot_) do { if (wid == 0) { _Pragma("unroll") for (int v_ = 0; v_ < Epi::NVEC; ++v_) { const char* gb_ = (const char*)E.evec(u_, v_); const unsigned lo_ = evbase + (unsigned)((slot_) * Epi::NVEC + v_) * 1024u; unsigned vo_ = __builtin_amdgcn_mbcnt_hi(~0u, __builtin_amdgcn_mbcnt_lo(~0u, 0u)) * 16u; PG8_DMA(gb_, lo_, vo_); } } } while (0)
    const unsigned evbase = (unsigned)(unsigned long)E.evl;
    PG8_EVEC(cur, 0);
    PG8_STAGE(PG8_SB(0, 0), cB, voffB); PG8_STAGE(PG8_SB(0, 1), cB + hstep, voffB); PG8_STAGE_A(PG8_SA(0, 0), cA, 0, 0); PG8_STAGE_A(PG8_SA(0, 1), cA, 1, 0);
    if (wr == 1) PG8_BAR;
    PG8_WAIT_V(2); PG8_BAR;
    PG8_STAGE(PG8_SB(1, 0), cB + kstep, voffB); PG8_STAGE_A(PG8_SA(1, 0), cA + kstep, 0, 0); PG8_STAGE(PG8_SB(1, 1), cB + hstep + kstep, voffB);
    PG8_WAIT_V(6); PG8_BAR;
    int pe_ = -1, pl0_ = 0;
    for (;;) {
        const bool has_next = has1; nxt = un1;
        const char* nA = has_next ? S.abase(nxt) : cA; const char* nB = has_next ? S.bbase(nxt) : cB;
        const int sc = ui & 3, sn = has_next ? ((ui + 1) & 3) : sc;
#define PG8_KITER(t, ZC) do { \
            const bool last = ((t) == nt - 2); \
            const char* a1 = cA + (size_t)((t) + 1) * kstep; \
            const char* a2 = last ? nA : cA + (size_t)((t) + 2) * kstep; const char* b2 = last ? nB : cB + (size_t)((t) + 2) * kstep; \
            const char* a3 = a2 + kstep; const char* b3 = b2 + kstep; \
            const int s2 = last ? sn : sc; \
            if (last && has_next) S.a_ready(nxt); \
              \
            PG8_LDB(B0, 0, 0); PG8_LDB(B1, 0, 1); PG8_SCHED; PG8_LDA(At, 0, 0); PG8_STAGE_A(PG8_SA(1, 1), a1, 1, sc); \
            PG8_WAIT_V(8); PG8_WAIT_L(0); PG8_BAR; PG8_MMA(0, 0, At, B0, ZC); PG8_MMA(0, 1, At, B1, ZC); PG8_BAR; PG8_SCHED; \
              \
            PG8_LDA(At, 0, 1); PG8_STAGE(PG8_SB(0, 0), b2, voffB); PG8_STAGE(PG8_SB(0, 1), b2 + hstep, voffB); PG8_STAGE_A(PG8_SA(0, 0), a2, 0, s2); \
            PG8_WAIT_V(8); PG8_WAIT_L(0); PG8_BAR; PG8_MMA(1, 0, At, B0, ZC); PG8_MMA(1, 1, At, B1, ZC); PG8_BAR; PG8_SCHED; \
              \
            PG8_LDB(B0, 1, 0); PG8_LDB(B1, 1, 1); PG8_SCHED; PG8_LDA(At, 1, 0); PG8_STAGE_A(PG8_SA(0, 1), a2, 1, s2); \
            PG8_WAIT_V(8); PG8_WAIT_L(0); PG8_BAR; PG8_MMA(0, 0, At, B0, false); PG8_MMA(0, 1, At, B1, false); PG8_BAR; PG8_SCHED; \
              \
            PG8_LDA(At, 1, 1); PG8_STAGE(PG8_SB(1, 0), b3, voffB); PG8_STAGE(PG8_SB(1, 1), b3 + hstep, voffB); PG8_STAGE_A(PG8_SA(1, 0), a3, 0, s2); \
            PG8_WAIT_V(8); PG8_WAIT_L(0); PG8_BAR; PG8_MMA(1, 0, At, B0, false); PG8_MMA(1, 1, At, B1, false); PG8_BAR; PG8_SCHED; } while (0)
        PG8_KITER(0, true);
        if (pe_ >= 0) S.signal(pe_, pl0_);
#pragma unroll 1
        for (int t = 2; t < nt; t += 2) PG8_KITER(t, false);
        if constexpr (ALIGN_EPI) { if (wr == 0) PG8_BAR; }
        { int l_ = (int)__builtin_amdgcn_mbcnt_hi(~0u, __builtin_amdgcn_mbcnt_lo(~0u, 0u)); asm volatile("" : "+v"(l_));
          E(acc, cur, wr, wc, l_ & 15, l_ >> 4, wid * 64 + l_, (const PG8_LAS float*)(E.evl + (ui & 1) * Epi::NVEC * 1024)); } S.done(cur); pe_ = cur.e; pl0_ = cur.l0;
        if (!has_next) break;
        un2 = cur; has2 = S.next(ui + 2, un2);
        if constexpr (GA) { if (has2) PG8_GFILL(un2, (ui + 2) & 3); }
        un1 = un2; has1 = has2;
        cur = nxt; cA = nA; cB = nB; ++ui;
        PG8_EVEC(cur, ui & 1);
        if constexpr (ALIGN_EPI) { if (wr == 1) PG8_BAR; }
    }
    PG8_WAIT_V(0);
    if constexpr (!ALIGN_EPI) { if (wr == 0) PG8_BAR; }
    PG8_BAR;
    if (pe_ >= 0) S.signal(pe_, pl0_);
#undef PG8_SA
#undef PG8_SB
#undef PG8_KITER
#undef PG8_EVEC
#undef PG8_DMA
#undef PG8_STAGE
#undef PG8_STAGE_A
#undef PG8_GFILL
#undef PG8_LD16
#undef PG8_LDA
#undef PG8_LDB
#undef PG8_MMA
#undef PG8_WAIT_V
#undef PG8_WAIT_L
#undef PG8_BAR
#undef PG8_SCHED
}
}

#ifndef PG8_SP2
#define PG8_SP2 true
#endif
#ifndef PG8_ALIGN
#define PG8_ALIGN true
#endif

constexpr int NWAVES = 8;
constexpr int NPH = 10;
constexpr int N_LAUNCHES = MK_N_LAUNCHES;
constexpr int T = 32768, D = 1024, NBATCH = 8, SEQ = 4096, IN_DIM = 6144, NE = 32, TOPK = 4, NMOD = 6144;
constexpr int NASSIGN = T * TOPK;
constexpr float LN_EPS = 1e-5f;
constexpr float DN_ALPHA = 1.189207115002721f;
constexpr int MOD_SHIFT1 = 0, MOD_SCALE1 = 1024, MOD_GATE1 = 2048, MOD_SHIFT2 = 3072, MOD_SCALE2 = 4096, MOD_GATE2 = 5120;

constexpr size_t MiB = 1u << 20;
constexpr size_t WS_CTL = 0, CTL_ZERO_BYTES = 48 * 1024;
constexpr size_t WS_MOD = 1 * MiB;
constexpr size_t WS_BINP = 1 * MiB + 256 * 1024;
constexpr size_t WS_BUPP = 1 * MiB + 320 * 1024;
constexpr size_t WS_WRT = 1 * MiB + 640 * 1024;
constexpr size_t WS_WSM = 1 * MiB + 768 * 1024;
constexpr size_t WS_TOK = 2 * MiB;
constexpr size_t WS_TOKE = 2 * MiB;
constexpr size_t WS_TOKW = 2 * MiB + 512 * 1024;
constexpr size_t WS_TOKR = 3 * MiB;
constexpr size_t WS_LIST = 4 * MiB;
constexpr size_t WS_WIN = 8 * MiB, WS_WPA = 20 * MiB, WS_WPB = 22 * MiB, WS_WOUT = 24 * MiB, WS_WUP = 26 * MiB, WS_WDN = 154 * MiB;
constexpr size_t UB = 64 * MiB;
constexpr size_t WS_R0 = 218 * MiB;
constexpr size_t WS_Z = WS_R0, WS_GU = WS_R0 + UB, WS_GV = WS_R0 + 2 * UB, WS_SGA = WS_R0 + 3 * UB, WS_SGB = WS_R0 + 4 * UB, WS_ACT = WS_R0;
constexpr size_t WS_R1 = 538 * MiB;
constexpr size_t WS_H = WS_R1, WS_AACT = WS_R1 + UB, WS_GATED = WS_R1 + 2 * UB, WS_MERGED = WS_R1 + 3 * UB, WS_XG = WS_R1, WS_Y = WS_R1, WS_M1 = WS_R1  , WS_YO = WS_R1 + 2 * UB;
constexpr size_t WS_X1 = WS_R0 + 2 * UB;
constexpr size_t WS_H2 = 795 * MiB;
constexpr size_t WS_END = 859 * MiB;
static_assert(WS_R0 + 5 * UB <= WS_R1 && WS_R1 + 4 * UB + MiB <= WS_H2 && WS_H2 + UB <= WS_END && WS_WDN + UB <= WS_R0 && WS_WUP + 2 * UB <= WS_WDN, "d_ws map");
static_assert((size_t)(NASSIGN + 256) * 2048 <= 4 * UB + MiB, "ACT / XG with 256 rows of slack");
constexpr int CW_BAR = 4096;
constexpr int CW_ECNT = 11776;
constexpr int CW_XRANK = 8192;
constexpr int CW_READY = 9216;

constexpr int RING_OFF = 0, RING_BYTES = 131072;
constexpr int LDSCTL_OFF = RING_BYTES, MISC_OFF = LDSCTL_OFF + 320;
constexpr int TBL_CNT = LDSCTL_OFF + 512, TBL_RS = LDSCTL_OFF + 640, TBL_TPU = LDSCTL_OFF + 784, TBL_TPD = LDSCTL_OFF + 928;
constexpr int RT_CNT = LDSCTL_OFF + 2048, RT_BASE = RT_CNT + 128, RT_RECE = RT_CNT + 256, RT_RECL = RT_RECE + 2048, RT_RECW = RT_RECL + 2048;
constexpr int PV6_OFF = LDSCTL_OFF + 8704;
constexpr int STG_OFF = LDSCTL_OFF + 1536;
constexpr int GTAB_OFF = LDSCTL_OFF + 19968;
constexpr int EVEC_OFF = LDSCTL_OFF + 28160;
constexpr int LDS_BYTES = 131072 + 28160 + 4096;
static_assert(STG_OFF + 18432 <= GTAB_OFF && GTAB_OFF + 8192 <= EVEC_OFF && LDS_BYTES <= 163840 && TBL_TPD + 144 <= STG_OFF, "LDS map");

#define GAS __attribute__((address_space(1)))
#define LAS __attribute__((address_space(3)))
typedef unsigned short bf16;
typedef unsigned v4u __attribute__((ext_vector_type(4)));
typedef unsigned v2u __attribute__((ext_vector_type(2)));
typedef float f32x4 __attribute__((ext_vector_type(4)));
typedef float f32x2 __attribute__((ext_vector_type(2)));
typedef short bf16x8 __attribute__((ext_vector_type(8)));
typedef GAS unsigned gu32;
#define RLX_AGENT __ATOMIC_RELAXED, __HIP_MEMORY_SCOPE_AGENT
#define LDS_WAIT() asm volatile("s_waitcnt lgkmcnt(0)" ::: "memory")
#define VM_WAIT() asm volatile("s_waitcnt vmcnt(0)" ::: "memory")
__device__ __forceinline__ unsigned f2bf(float f) { unsigned u = __builtin_bit_cast(unsigned, f); return (u + 0x7fffu + ((u >> 16) & 1u)) >> 16; }
__device__ __forceinline__ unsigned pk2(float lo, float hi) { return f2bf(lo) | (f2bf(hi) << 16); }
__device__ __forceinline__ float bflo(unsigned w) { return __uint_as_float(w << 16); }
__device__ __forceinline__ unsigned pk2r(float a, float b) { unsigned r; asm("v_cvt_pk_bf16_f32 %0, %1, %2" : "=v"(r) : "v"(a), "v"(b)); return r; }
__device__ __forceinline__ v2u split_bf16(float a, float b) { unsigned hi, lo; asm("v_cvt_pk_bf16_f32 %0, %1, %2" : "=v"(hi) : "v"(a), "v"(b)); const float ra = a - __uint_as_float(hi << 16), rb = b - __uint_as_float(hi & 0xffff0000u); asm("v_cvt_pk_bf16_f32 %0, %1, %2" : "=v"(lo) : "v"(ra), "v"(rb)); return (v2u){hi, lo}; }
__device__ __forceinline__ float bfhi(unsigned w) { return __uint_as_float(w & 0xffff0000u); }

#define XB_TMO      128
#define XB_XCNT(j)  (256  + 64 * (j))
#define XB_XSUB(j)  (1280 + 64 * (j))
#define XB_XGEN(j)  (2304 + 64 * (j))
#define XB_TOP      3328
#define XB_TOPGEN   3392
#define XCD_BAR_WORDS 3456
#define XB_SPIN_CAP (1u << 18)
__device__ __forceinline__ unsigned xb_ld(unsigned* p)              { return __hip_atomic_load(p, __ATOMIC_RELAXED, __HIP_MEMORY_SCOPE_AGENT); }
__device__ __forceinline__ unsigned xb_add(unsigned* p, unsigned v) { return __hip_atomic_fetch_add(p, v, __ATOMIC_RELAXED, __HIP_MEMORY_SCOPE_AGENT); }
__device__ __forceinline__ unsigned xb_xcc_id() { return (unsigned)__builtin_amdgcn_s_getreg((3 << 11) | 20) & 0xFu; }
#define XB_SPIN(cond, bar) do { unsigned _sp = 0; while (cond) { __builtin_amdgcn_s_sleep(1); \
    if ((++_sp & 255u) == 0u) { if (xb_ld(&(bar)[XB_TMO])) break; if (_sp > XB_SPIN_CAP) { atomicAdd(&(bar)[XB_TMO], 1u); break; } } } } while (0)
struct XcdBarrier { unsigned* bar; unsigned x; volatile LAS unsigned* st; };
__device__ __forceinline__ XcdBarrier xcd_barrier_post(unsigned* bar, volatile LAS unsigned* st) {
    XcdBarrier b; b.bar = bar; b.x = xb_xcc_id(); b.st = st;
    if (threadIdx.x == 0) (void)xb_add(&bar[XB_XCNT(b.x)], 1u);
    return b;
}
__device__ __forceinline__ void xcd_barrier_complete(unsigned* bar, unsigned x, unsigned& nloc, unsigned& nx) {
    const unsigned G = gridDim.x * gridDim.y * gridDim.z;
    unsigned sum, cnt, mine, sp = 0u;
    for (;;) {
        sum = 0u; cnt = 0u; mine = 0u;
#pragma unroll
        for (unsigned j = 0; j < 16; ++j) { const unsigned c = xb_ld(&bar[XB_XCNT(j)]); sum += c; cnt += (c > 0u) ? 1u : 0u; mine = (j == x) ? c : mine; }
        if (sum == G) break;
        __builtin_amdgcn_s_sleep(1);
        if ((++sp & 255u) == 0u) { if (xb_ld(&bar[XB_TMO])) break; if (sp > XB_SPIN_CAP) { atomicAdd(&bar[XB_TMO], 1u); break; } }
    }
    nloc = mine > 0u ? mine : 1u; nx = cnt > 0u ? cnt : 1u;
}
__device__ __forceinline__ void xcd_barrier(const XcdBarrier& b) {
    asm volatile("s_waitcnt vmcnt(0)" ::: "memory");
    __syncthreads();
    if (threadIdx.x == 0) {
        unsigned* bar = b.bar;
        __builtin_amdgcn_s_waitcnt(0);
        unsigned nloc = b.st[0], nx = b.st[1];
        if (nloc == 0u) { xcd_barrier_complete(bar, b.x, nloc, nx); b.st[0] = nloc; b.st[1] = nx; }
        const unsigned old = xb_add(&bar[XB_XSUB(b.x)], 1u);
        const unsigned gen = old / nloc;
        if (old + 1u == (gen + 1u) * nloc) {
            __builtin_amdgcn_fence(__ATOMIC_RELEASE, "agent");
            asm volatile("s_waitcnt vmcnt(0)" ::: "memory");
            const unsigned og = xb_add(&bar[XB_TOP], 1u);
            const unsigned tg = og / nx;
            if (og + 1u == (tg + 1u) * nx) xb_add(&bar[XB_TOPGEN], 1u);
            else XB_SPIN(xb_ld(&bar[XB_TOPGEN]) == tg, bar);
            __builtin_amdgcn_fence(__ATOMIC_ACQUIRE, "agent");
            xb_add(&bar[XB_XGEN(b.x)], 1u);
            asm volatile("s_waitcnt vmcnt(0)" ::: "memory");
        } else {
            XB_SPIN(xb_ld(&bar[XB_TOPGEN]) == gen, bar);
            __builtin_amdgcn_fence(__ATOMIC_ACQUIRE, "agent");
            asm volatile("s_waitcnt vmcnt(0)" ::: "memory");
        }
    }
    __syncthreads();
}

struct Frame {
    LAS unsigned char* lds;
    volatile LAS unsigned* MISC;
    gu32* ctl;
    int tid, lane, wave;
    int vcu, G;
    unsigned char* ws; float* out;
    const __attribute__((address_space(4))) char* karg;
};
#define INP(i) (*(const float* const __attribute__((address_space(4)))*)(F.karg + 8 * (i)))
enum { I_X = 0, I_C, I_WADA, I_BADA, I_WIN, I_BIN, I_CONVW, I_CONVB, I_LNAG, I_LNAB, I_WPA, I_BPA, I_LNVG, I_LNVB, I_WS, I_BS, I_WPB, I_BPB, I_WOUT, I_BOUT, I_P1G, I_P1B,
       I_WR, I_BR, I_WUP, I_BUP, I_WDN, I_BDN, I_P2G, I_P2B };

__device__ __forceinline__ float sel_mask(float a, float b, unsigned long long mask) { float r; asm volatile("v_cndmask_b32 %0, %1, %2, %3" : "=v"(r) : "v"(a), "v"(b), "s"(mask)); return r; }
#define DPP_F(v, ctrl) __builtin_bit_cast(float, __builtin_amdgcn_update_dpp(0, __builtin_bit_cast(int, (v)), (ctrl), 0xf, 0xf, true))
#define DPP_I(v, ctrl) __builtin_amdgcn_update_dpp(0, (v), (ctrl), 0xf, 0xf, true)
constexpr int DPP_XOR1 = 0xB1, DPP_XOR2 = 0x4E, DPP_HMIRROR = 0x141, DPP_MIRROR = 0x140;
template <int O> __device__ __forceinline__ float tr_xchg(float give) {
    const unsigned g = __float_as_uint(give);
    if constexpr (O == 32) { const auto r = __builtin_amdgcn_permlane32_swap(g, g, false, false); return sel_mask(__uint_as_float(r[1]), __uint_as_float(r[0]), 0xFFFFFFFF00000000ull); }
    else if constexpr (O == 16) { const auto r = __builtin_amdgcn_permlane16_swap(g, g, false, false); return sel_mask(__uint_as_float(r[1]), __uint_as_float(r[0]), 0xFFFF0000FFFF0000ull); }
    else if constexpr (O == 8) return DPP_F(give, 0x128);
    else return DPP_F(give, DPP_HMIRROR);
}
__device__ __forceinline__ float wave_sum(float v) {
    v += DPP_F(v, DPP_XOR1); v += DPP_F(v, DPP_XOR2); v += DPP_F(v, DPP_HMIRROR); v += DPP_F(v, DPP_MIRROR);
    const int iv = __builtin_bit_cast(int, v);
    const float r0 = __builtin_bit_cast(float, __builtin_amdgcn_readlane(iv, 0)), r1 = __builtin_bit_cast(float, __builtin_amdgcn_readlane(iv, 16)), r2 = __builtin_bit_cast(float, __builtin_amdgcn_readlane(iv, 32)), r3 = __builtin_bit_cast(float, __builtin_amdgcn_readlane(iv, 48));
    return (r0 + r1) + (r2 + r3);
}
__device__ __forceinline__ int glu_map(int c) { if (c >= 2048) return c; const int bj = c >> 10, q = c & 1023; return ((q >> 7) << 8) + (bj << 7) + (q & 127); }

__device__ __forceinline__ void p0_transpose_item(const float* W, int K, int N, bf16* WT, int drow0, LAS float* scr, int k0, int n0, int lane) {
#pragma unroll 8
    for (int i = 0; i < 32; ++i) { const int kk = 2 * i + (lane >> 5); scr[kk * 33 + (lane & 31)] = W[(size_t)(k0 + kk) * N + n0 + (lane & 31)]; }
    LDS_WAIT(); asm volatile("" ::: "memory");
    const int c = lane & 7;
#pragma unroll
    for (int j = 0; j < 4; ++j) { const int n = (lane >> 3) + 8 * j; const LAS float* s = scr + (8 * c) * 33 + n;
        v4u o; o.x = pk2(s[0 * 33], s[1 * 33]); o.y = pk2(s[2 * 33], s[3 * 33]); o.z = pk2(s[4 * 33], s[5 * 33]); o.w = pk2(s[6 * 33], s[7 * 33]);
        *(GAS v4u*)(WT + (size_t)(drow0 + n) * K + k0 + 8 * c) = o; }
    LDS_WAIT(); asm volatile("" ::: "memory");
}

__device__ __forceinline__ void p0_transpose_item8(const float* W, int K, int N, unsigned char* WT, int drow0, LAS float* scr, int k0, int n0, int lane, float scale) {
#pragma unroll 8
    for (int i = 0; i < 32; ++i) { const int kk = 2 * i + (lane >> 5); scr[kk * 33 + (lane & 31)] = W[(size_t)(k0 + kk) * N + n0 + (lane & 31)] * scale; }
    LDS_WAIT(); asm volatile("" ::: "memory");
    const int c = lane & 3;
#pragma unroll
    for (int j = 0; j < 2; ++j) { const int n = (lane >> 2) + 16 * j; const LAS float* s = scr + (16 * c) * 33 + n;
        v4u o; o.x = pg8::pk4_fp8(s[0 * 33], s[1 * 33], s[2 * 33], s[3 * 33]); o.y = pg8::pk4_fp8(s[4 * 33], s[5 * 33], s[6 * 33], s[7 * 33]);
        o.z = pg8::pk4_fp8(s[8 * 33], s[9 * 33], s[10 * 33], s[11 * 33]); o.w = pg8::pk4_fp8(s[12 * 33], s[13 * 33], s[14 * 33], s[15 * 33]);
        *(GAS v4u*)(WT + (size_t)(drow0 + n) * K + k0 + 16 * c) = o; }
    LDS_WAIT(); asm volatile("" ::: "memory");
}

__device__ __forceinline__ void p0_prologue(Frame& F) {
    {
        LAS float* cond = (LAS float*)(F.lds + RING_OFF);
        LAS float* red = (LAS float*)(F.lds + RING_OFF + 32768);
        const float* c = INP(I_C); const float* wada = INP(I_WADA); const float* bada = INP(I_BADA); float* mod = (float*)(F.ws + WS_MOD);
        bool loaded = false;
        for (int it = blockIdx.x; it < NMOD / 32; it += F.G) {
            if (!loaded) { for (int i = F.tid; i < NBATCH * D; i += NWAVES * 64) { const float v = c[i]; cond[i] = v / (1.0f + __expf(-v)); } loaded = true; }
            __syncthreads();
            const int col = F.lane & 31, kh = F.lane >> 5, n0 = it * 32;
            float a[NBATCH];
#pragma unroll
            for (int b = 0; b < NBATCH; ++b) a[b] = 0.f;
#pragma unroll 8
            for (int i = 0; i < 64; ++i) { const int k = F.wave * 128 + 2 * i + kh; const float w = wada[(size_t)k * NMOD + n0 + col];
#pragma unroll
                for (int b = 0; b < NBATCH; ++b) a[b] += cond[b * D + k] * w; }
#pragma unroll
            for (int b = 0; b < NBATCH; ++b) { a[b] += __shfl_xor(a[b], 32); if (F.lane < 32) red[(F.wave * NBATCH + b) * 32 + col] = a[b]; }
            __syncthreads();
            if (F.tid < 256) { const int b = F.tid >> 5, cc = F.tid & 31; float s = bada[n0 + cc];
#pragma unroll
                for (int w = 0; w < NWAVES; ++w) s += red[(w * NBATCH + b) * 32 + cc];
                mod[b * NMOD + n0 + cc] = s; }
            __syncthreads();
        }
        __syncthreads();
    }
    {
        const int gt = (F.vcu * NWAVES + F.wave) * 64 + F.lane, NGT = F.G * NWAVES * 64;
        float* binp = (float*)(F.ws + WS_BINP); float* bupp = (float*)(F.ws + WS_BUPP); float* wrt = (float*)(F.ws + WS_WRT);
        for (int i = gt; i < IN_DIM; i += NGT) binp[glu_map(i)] = INP(I_BIN)[i];
        for (int i = gt; i < NE * 2048; i += NGT) { const int e = i >> 11, cc = i & 2047; bupp[e * 2048 + glu_map(cc)] = INP(I_BUP)[i]; }
        for (int i = gt; i < D * NE; i += NGT) { const int cc = i >> 5, e = i & 31; wrt[e * D + cc] = INP(I_WR)[i]; }
        bf16* wsm = (bf16*)(F.ws + WS_WSM);
        for (int i = gt; i < 8 * 128 * 128; i += NGT) { const int tt = (i >> 7) & 127, ss = i & 127; wsm[i] = (bf16)f2bf(ss <= tt ? INP(I_WS)[i] : 0.f); }
    }
    {
        LAS float* scr = (LAS float*)(F.lds + RING_OFF + F.wave * 16384);
        const int bx_ = blockIdx.x, ng_ = NMOD / 32, rk_ = (F.G > ng_) ? (bx_ >= ng_ ? bx_ - ng_ : bx_ + (F.G - ng_)) : F.vcu;
        const int gw = rk_ * NWAVES + F.wave, NGW = F.G * NWAVES;
        constexpr int I_IN = 16 * 192, I_SQ = 16 * 32;
        constexpr int NITEMS = I_IN + 3 * I_SQ;
        for (int it = gw; it < NITEMS; it += NGW) {
            int r = it;
            if (r < I_IN) { const int kb = r / 192, nb = r % 192; p0_transpose_item8(INP(I_WIN), D, IN_DIM, (unsigned char*)(F.ws + WS_WIN), glu_map(32 * nb), scr, 64 * kb, 32 * nb, F.lane, pg8::W8_SCALE); continue; } r -= I_IN;
            if (r < I_SQ) { const int kb = r / 32, nb = r % 32; p0_transpose_item8(INP(I_WPA), D, D, (unsigned char*)(F.ws + WS_WPA), 32 * nb, scr, 64 * kb, 32 * nb, F.lane, pg8::W8_SCALE); continue; } r -= I_SQ;
            if (r < I_SQ) { const int kb = r / 32, nb = r % 32; p0_transpose_item8(INP(I_WPB), D, D, (unsigned char*)(F.ws + WS_WPB), 32 * nb, scr, 64 * kb, 32 * nb, F.lane, pg8::W8_SCALE); continue; } r -= I_SQ;
            { const int kb = r / 32, nb = r % 32; p0_transpose_item8(INP(I_WOUT), D, D, (unsigned char*)(F.ws + WS_WOUT), 32 * nb, scr, 64 * kb, 32 * nb, F.lane, pg8::W8_SCALE); }
        }
    }
}
#ifndef MOE_N0
#define MOE_N0 28
#define MOE_N1 22
#endif
#ifndef MOE_NA
#define MOE_NA 27
#endif
__device__ __forceinline__ void p0_moe_weights(Frame& F, const int ty, const int tr) {
    LAS float* scr = (LAS float*)(F.lds + RING_OFF + F.wave * 16384);
    constexpr int I_UP = NE * 16 * 64, I_DN = NE * 16 * 32;
    const int nty = (F.G * NWAVES) >> 1;
    constexpr int N0 = MOE_N0, N1 = MOE_N1, N2 = 96 - 2 * MOE_N0 - MOE_N1; static_assert(N2 > 0, "shares");
    const int h_ = nty >> 1;
    const int first = ty < 0 ? F.vcu * NWAVES + F.wave : (ty == 0 ? tr : (ty == 1 ? nty * N0 + tr : nty * N0 + h_ * N1 + tr)), step = ty < 0 ? F.G * NWAVES : (ty == 0 ? nty : h_),
              end = ty < 0 ? I_UP + I_DN : (ty == 0 ? nty * N0 : (ty == 1 ? nty * N0 + h_ * N1 : I_UP + I_DN));
    for (int it = first; it < end; it += step) {
        int r = it;
        if (r < I_UP) { const int e = r >> 10, rr = r & 1023, kb = rr >> 6, nb = rr & 63;
            p0_transpose_item8(INP(I_WUP) + (size_t)e * D * 2048, D, 2048, (unsigned char*)(F.ws + WS_WUP) + (size_t)e * 2048 * D, glu_map(32 * nb), scr, 64 * kb, 32 * nb, F.lane, pg8::W8_SCALE); continue; } r -= I_UP;
        { const int e = r >> 9, rr = r & 511, kb = rr >> 5, nb = rr & 31;
            p0_transpose_item8(INP(I_WDN) + (size_t)e * D * D, D, D, (unsigned char*)(F.ws + WS_WDN) + (size_t)e * D * D, 32 * nb, scr, 64 * kb, 32 * nb, F.lane, pg8::W8_SCALE); }
    }
    __syncthreads();
}

__device__ __forceinline__ void p1_lnmod(Frame& F, const int xlocal, const int cx, unsigned* rdy) {
    const int vcu = xlocal ? (cx & 7) * (F.G >> 3) + (cx >> 3) : F.vcu;
    const int gw = vcu * NWAVES + F.wave, NGW = F.G * NWAVES, RPW = (T + NGW - 1) / NGW;
    const int r0 = gw * RPW, r1 = (r0 + RPW) < T ? (r0 + RPW) : T;
    const float* mod = (const float*)(F.ws + WS_MOD); unsigned char* H = (unsigned char*)(F.ws + WS_H);
    int curb = -1; f32x4 sc[4], sh[4];
    for (int r = r0; r < r1; ++r) {
        const int b = r >> 12;
        if (b != curb) { curb = b;
#pragma unroll
            for (int j = 0; j < 4; ++j) { sc[j] = *(const f32x4*)(mod + b * NMOD + MOD_SCALE1 + 4 * F.lane + 256 * j) + 1.0f; sh[j] = *(const f32x4*)(mod + b * NMOD + MOD_SHIFT1 + 4 * F.lane + 256 * j); } }
        const f32x4* xr = (const f32x4*)(INP(I_X) + (size_t)r * D) + F.lane;
        f32x4 v[4]; float s = 0.f;
#pragma unroll
        for (int j = 0; j < 4; ++j) { v[j] = xr[64 * j]; s += (v[j].x + v[j].y) + (v[j].z + v[j].w); }
        const float mean = wave_sum(s) * (1.f / D); float s2 = 0.f;
#pragma unroll
        for (int j = 0; j < 4; ++j) { v[j] = v[j] - mean; s2 += (v[j].x * v[j].x + v[j].y * v[j].y) + (v[j].z * v[j].z + v[j].w * v[j].w); }
        const float rstd = __builtin_amdgcn_rsqf(wave_sum(s2) * (1.f / D) + LN_EPS);
        unsigned* o4 = (unsigned*)(H + (size_t)r * D) + F.lane;
#pragma unroll
        for (int j = 0; j < 4; ++j) { const f32x4 h = v[j] * rstd * sc[j] + sh[j]; o4[64 * j] = pg8::pk4_fp8(h.x, h.y, h.z, h.w); }
    }
    if (xlocal) { asm volatile("s_waitcnt vmcnt(0)" ::: "memory"); __syncthreads();
        if (F.tid == 0) (void)__hip_atomic_fetch_add(rdy + ((vcu * NWAVES * RPW) >> 8), 1u, RLX_AGENT); }
}

__device__ __forceinline__ void p3_conv_unit(Frame& F, int u) {
    const int c0 = 2 * F.tid, g0 = u * 128, t0 = (u & 31) * 128;
    const bf16* Z = (const bf16*)(F.ws + WS_Z); unsigned char* AACT = (unsigned char*)(F.ws + WS_AACT);
    LAS float* wl = (LAS float*)(F.lds + RING_OFF);
    LAS float* red = (LAS float*)(F.lds + RING_OFF + 126976);
    { const f32x4* wsrc = (const f32x4*)INP(I_CONVW); f32x4 t[16];
#pragma unroll
      for (int k = 0; k < 16; ++k) { const int i = F.tid + k * NWAVES * 64; t[k] = wsrc[i < 31 * D / 4 ? i : F.tid]; }
#pragma unroll
      for (int k = 0; k < 16; ++k) { const int i = F.tid + k * NWAVES * 64; if (i < 31 * D / 4) ((LAS f32x4*)wl)[i] = t[k]; } }
    __syncthreads();
    unsigned wa_off = (unsigned)(RING_OFF + c0 * 4), wb_off = (unsigned)(RING_OFF + 16 * D * 4 + c0 * 4);
    asm volatile("" : "+v"(wa_off), "+v"(wb_off));
    const LAS unsigned char* wA = F.lds + wa_off; const LAS unsigned char* wB = F.lds + wb_off;
    const f32x2 cb = *(const f32x2*)(INP(I_CONVB) + c0), lg = *(const f32x2*)(INP(I_LNAG) + c0), lb = *(const f32x2*)(INP(I_LNAB) + c0);
    f32x2 zp[38]; unsigned zn[8];
    { const bf16* zh = Z + (size_t)(t0 > 0 ? g0 - 30 : g0) * D + c0; const unsigned msk = t0 > 0 ? 0xffffffffu : 0u;
#pragma unroll
      for (int i = 0; i < 30; ++i) { const unsigned p = *(const unsigned*)(zh + (size_t)i * D) & msk; zp[i] = (f32x2){bflo(p), bfhi(p)}; }
      const bf16* zr = Z + (size_t)g0 * D + c0;
#pragma unroll
      for (int r = 0; r < 8; ++r) zn[r] = *(const unsigned*)(zr + (size_t)r * D); }
#pragma unroll 1
    for (int ch = 0; ch < 16; ++ch) {
        unsigned char* orow = AACT + (size_t)(g0 + ch * 8) * D + c0;
#pragma unroll
        for (int r = 0; r < 8; ++r) zp[30 + r] = (f32x2){bflo(zn[r]), bfhi(zn[r])};
        { const bf16* zr = Z + (size_t)(g0 + (ch < 15 ? ch + 1 : ch) * 8) * D + c0;
#pragma unroll
          for (int r = 0; r < 8; ++r) zn[r] = *(const unsigned*)(zr + (size_t)r * D); }
        f32x2 op[8]; float sv[16];
#pragma unroll
        for (int r = 0; r < 8; ++r) op[r] = cb;
#pragma unroll
        for (int j = 0; j < 31; ++j) { const f32x2 w = (j < 16) ? *(const LAS f32x2*)(wA + j * D * 4) : *(const LAS f32x2*)(wB + (j - 16) * D * 4);
#pragma unroll
            for (int r = 0; r < 8; ++r) op[r] = __builtin_elementwise_fma(w, zp[r + j], op[r]);
            if ((j & 7) == 7) __builtin_amdgcn_sched_barrier(0); }
#pragma unroll
        for (int r = 0; r < 8; ++r) { const f32x2 q = op[r] * op[r]; sv[r] = op[r].x + op[r].y; sv[8 + r] = q.x + q.y; }
#define TR_STEP(o, n, mk) { unsigned long long m_ = (mk); asm volatile("" : "+s"(m_)); _Pragma("unroll") for (int k = 0; k < (n); ++k) { const float keep = sel_mask(sv[k], sv[k + (n)], m_), give = sel_mask(sv[k + (n)], sv[k], m_); sv[k] = keep + tr_xchg<(o)>(give); } }
        TR_STEP(32, 8, 0xFFFFFFFF00000000ull) TR_STEP(16, 4, 0xFFFF0000FFFF0000ull) TR_STEP(8, 2, 0xFF00FF00FF00FF00ull) TR_STEP(4, 1, 0xF0F0F0F0F0F0F0F0ull)
#undef TR_STEP
        sv[0] += DPP_F(sv[0], DPP_XOR2); sv[0] += DPP_F(sv[0], DPP_XOR1);
        LAS float* rd = red + (ch & 1) * 128;
        if ((F.lane & 3) == 0) rd[F.wave * 16 + (F.lane >> 2)] = sv[0];
        __syncthreads();
        float tot_ = 0.f;
#pragma unroll
        for (int w = 0; w < NWAVES; ++w) tot_ += rd[w * 16 + (F.lane & 15)];
        const float sq_ = DPP_F(tot_, 0x128);
        const float mean_ = tot_ * (1.f / D), rstd_ = __builtin_amdgcn_rsqf(fmaxf(sq_ * (1.f / D) - mean_ * mean_, 0.f) + LN_EPS);
#pragma unroll
        for (int r = 0; r < 8; ++r) { const float mean = __uint_as_float(__builtin_amdgcn_readlane(__float_as_uint(mean_), r)), rstd = __uint_as_float(__builtin_amdgcn_readlane(__float_as_uint(rstd_), r));
            const f32x2 y = (op[r] - mean) * rstd * lg + lb;
            const f32x2 e = {__builtin_amdgcn_exp2f(-1.44269504089f * y.x), __builtin_amdgcn_exp2f(-1.44269504089f * y.y)}; const f32x2 d = e + 1.0f;
            const f32x2 o = y * (f32x2){__builtin_amdgcn_rcpf(d.x), __builtin_amdgcn_rcpf(d.y)};
            *(unsigned short*)(orow + (size_t)r * D) = (unsigned short)pg8::pk4_fp8_raw(o.x, o.y, 0.f, 0.f); }
#pragma unroll
        for (int i = 0; i < 30; ++i) zp[i] = zp[i + 8];
    }
    __syncthreads();
}

template <int OFF> __device__ __forceinline__ void tr_read8(v2u (&r)[8], const unsigned (&a)[8]) {
    asm volatile("ds_read_b64_tr_b16 %0, %8 offset:%16\n\tds_read_b64_tr_b16 %1, %9 offset:%16\n\tds_read_b64_tr_b16 %2, %10 offset:%16\n\tds_read_b64_tr_b16 %3, %11 offset:%16\n\t"
                 "ds_read_b64_tr_b16 %4, %12 offset:%16\n\tds_read_b64_tr_b16 %5, %13 offset:%16\n\tds_read_b64_tr_b16 %6, %14 offset:%16\n\tds_read_b64_tr_b16 %7, %15 offset:%16\n\ts_waitcnt lgkmcnt(0)"
                 : "=&v"(r[0]), "=&v"(r[1]), "=&v"(r[2]), "=&v"(r[3]), "=&v"(r[4]), "=&v"(r[5]), "=&v"(r[6]), "=&v"(r[7])
                 : "v"(a[0]), "v"(a[1]), "v"(a[2]), "v"(a[3]), "v"(a[4]), "v"(a[5]), "v"(a[6]), "v"(a[7]), "i"(OFF) : "memory");
}
template <int KS> __device__ __forceinline__ void mix_kstep(f32x4 (&acc)[8], const LAS unsigned short* Wl, int wrow, int fq, const unsigned (&a0)[8], const unsigned (&a1)[8]) {
    const bf16x8 wf = *(const LAS bf16x8*)(Wl + wrow * 136 + 32 * KS + 8 * fq);
    v2u r0[8], r1[8];
    tr_read8<KS * 8192>(r0, a0); tr_read8<KS * 8192 + 1024>(r1, a1);
    __builtin_amdgcn_sched_barrier(0);
#pragma unroll
    for (int c = 0; c < 8; ++c) { const v4u vv = {r0[c].x, r0[c].y, r1[c].x, r1[c].y}; acc[c] = __builtin_amdgcn_mfma_f32_16x16x32_bf16((bf16x8)vv, wf, acc[c], 0, 0, 0); }
}
__device__ __forceinline__ void p3_mix_unit(Frame& F, int u) {
    constexpr int LP = 136, VS_OFF = 34816, ST_OFF = 67584;
    LAS unsigned short* Wl = (LAS unsigned short*)(F.lds + RING_OFF);
    LAS unsigned char* Vs = F.lds + RING_OFF + VS_OFF;
    LAS float* st = (LAS float*)(F.lds + RING_OFF + ST_OFF);
    const bf16* GV = (const bf16*)(F.ws + WS_GV); const bf16* GU = (const bf16*)(F.ws + WS_GU); unsigned char* GATED = (unsigned char*)(F.ws + WS_GATED); const bf16* WSM = (const bf16*)(F.ws + WS_WSM);
    const int g0 = u * 128, fr = F.lane & 15, fq = F.lane >> 4;
#pragma unroll 1
    for (int hb = 0; hb < 2; ++hb) {
        v4u ra[8], rb[8];
#pragma unroll
        for (int i = 0; i < 8; ++i) { const bf16* row = GV + (size_t)(g0 + F.wave * 16 + hb * 8 + i) * D; ra[i] = *(const v4u*)(row + 8 * F.lane); rb[i] = *(const v4u*)(row + 512 + 8 * F.lane); }
        float sv[16];
#pragma unroll
        for (int i = 0; i < 8; ++i) { float sm = 0.f, sq = 0.f;
#pragma unroll
            for (int j = 0; j < 4; ++j) { const float x0 = bflo(ra[i][j]), x1 = bfhi(ra[i][j]), x2 = bflo(rb[i][j]), x3 = bfhi(rb[i][j]); sm += (x0 + x1) + (x2 + x3); sq += (x0 * x0 + x1 * x1) + (x2 * x2 + x3 * x3); }
            sv[i] = sm; sv[8 + i] = sq; }
#define TR_STEP(o, n, mk) { unsigned long long m_ = (mk); asm volatile("" : "+s"(m_)); _Pragma("unroll") for (int k = 0; k < (n); ++k) { const float keep = sel_mask(sv[k], sv[k + (n)], m_), give = sel_mask(sv[k + (n)], sv[k], m_); sv[k] = keep + tr_xchg<(o)>(give); } }
        TR_STEP(32, 8, 0xFFFFFFFF00000000ull) TR_STEP(16, 4, 0xFFFF0000FFFF0000ull) TR_STEP(8, 2, 0xFF00FF00FF00FF00ull) TR_STEP(4, 1, 0xF0F0F0F0F0F0F0F0ull)
#undef TR_STEP
        sv[0] += DPP_F(sv[0], DPP_XOR2); sv[0] += DPP_F(sv[0], DPP_XOR1);
        const float other = tr_xchg<32>(sv[0]);
        if (F.lane < 32 && (F.lane & 3) == 0) { const int s = F.wave * 16 + hb * 8 + (F.lane >> 2); const float mu = sv[0] * (1.f / D), var = other * (1.f / D) - mu * mu; st[s] = mu; st[128 + s] = __builtin_amdgcn_rsqf(fmaxf(var, 0.f) + LN_EPS); }
    }
    unsigned a0[8], a1[8];
    { const unsigned g = F.lane >> 4, q = (F.lane & 15) >> 2, p = F.lane & 3, lb = (unsigned)(unsigned long)Vs + 256u * (8u * g + q) + 8u * (p & 1), x0 = (q << 2) | ((2u * g) & 3u), x1 = (q << 2) | ((2u * g + 1u) & 3u);
#pragma unroll
      for (int c = 0; c < 8; ++c) { a0[c] = lb + 16u * ((2u * c + (p >> 1)) ^ x0); a1[c] = lb + 16u * ((2u * c + (p >> 1)) ^ x1); } }
    const int rr = F.tid >> 4, cc = F.tid & 15;
    const int t = 16 * F.wave + fr;
    constexpr int OS_OFF = 69632, OSP = 144, PRM_OFF = 88064;
    LAS unsigned char* os = F.lds + RING_OFF + OS_OFF; LAS float* prm = (LAS float*)(F.lds + RING_OFF + PRM_OFF);
    { const f32x2 p0 = *(const f32x2*)(INP(I_LNVG) + 2 * F.tid), p1 = *(const f32x2*)(INP(I_LNVB) + 2 * F.tid), p2 = *(const f32x2*)(INP(I_BS) + 2 * F.tid);
      *(LAS f32x2*)(prm + 2 * F.tid) = p0; *(LAS f32x2*)(prm + D + 2 * F.tid) = p1; *(LAS f32x2*)(prm + 2 * D + 2 * F.tid) = p2; }
    v4u wA[4], vA[4], wB[4], vB[4]; v2u gA[8], gB[8];
    auto mload = [&](const int h, v4u (&w)[4], v4u (&v)[4], v2u (&g)[8]) __attribute__((always_inline)) {
#pragma unroll
        for (int i = 0; i < 4; ++i) { w[i] = *(const v4u*)(WSM + (size_t)h * 16384 + (rr + 32 * i) * 128 + cc * 8); v[i] = *(const v4u*)(GV + (size_t)(g0 + rr + 32 * i) * D + h * 128 + cc * 8); }
#pragma unroll
        for (int dn = 0; dn < 8; ++dn) g[dn] = *(const v2u*)(GU + (size_t)(g0 + t) * D + h * 128 + 16 * dn + 4 * fq); };
    auto head = [&](const int h, const v4u (&w)[4], const v4u (&v)[4], const v2u (&g)[8]) __attribute__((always_inline)) {
        { const f32x4 g0v = *(const LAS f32x4*)(prm + h * 128 + cc * 8), g1v = *(const LAS f32x4*)(prm + h * 128 + cc * 8 + 4), b0v = *(const LAS f32x4*)(prm + D + h * 128 + cc * 8), b1v = *(const LAS f32x4*)(prm + D + h * 128 + cc * 8 + 4);
#pragma unroll
          for (int i = 0; i < 4; ++i) { const int s_ = rr + 32 * i;
            *(LAS v4u*)(Wl + s_ * LP + cc * 8) = w[i];
            const float mu = st[s_], rs = st[128 + s_];
            f32x4 x0 = {bflo(v[i].x), bfhi(v[i].x), bflo(v[i].y), bfhi(v[i].y)}, x1 = {bflo(v[i].z), bfhi(v[i].z), bflo(v[i].w), bfhi(v[i].w)};
            x0 = (x0 - mu) * rs * g0v + b0v; x1 = (x1 - mu) * rs * g1v + b1v;
            v4u o; o.x = pk2(x0.x, x0.y); o.y = pk2(x0.z, x0.w); o.z = pk2(x1.x, x1.y); o.w = pk2(x1.z, x1.w);
            *(LAS v4u*)(Vs + 256 * s_ + 16 * (cc ^ (((s_ & 3) << 2) | ((s_ >> 2) & 3)))) = o; } }
        const float bs = prm[2 * D + h * 128 + t];
        __syncthreads();
        f32x4 acc[8];
#pragma unroll
        for (int c = 0; c < 8; ++c) acc[c] = (f32x4){0.f, 0.f, 0.f, 0.f};
        const int ksmax = F.wave >> 1;
        mix_kstep<0>(acc, Wl, 16 * F.wave + fr, fq, a0, a1);
        if (ksmax >= 1) mix_kstep<1>(acc, Wl, 16 * F.wave + fr, fq, a0, a1);
        if (ksmax >= 2) mix_kstep<2>(acc, Wl, 16 * F.wave + fr, fq, a0, a1);
        if (ksmax >= 3) mix_kstep<3>(acc, Wl, 16 * F.wave + fr, fq, a0, a1);
#pragma unroll
        for (int dn = 0; dn < 8; ++dn) { const f32x4 gq = {bflo(g[dn].x), bfhi(g[dn].x), bflo(g[dn].y), bfhi(g[dn].y)}; const f32x4 o = (acc[dn] + bs) * gq;
            *(LAS unsigned*)(os + t * OSP + 16 * dn + 4 * fq) = pg8::pk4_fp8(o.x, o.y, o.z, o.w); }
        __syncthreads();
#pragma unroll
        for (int i = 0; i < 2; ++i) { const int row = (F.tid >> 3) + 64 * i, c16 = F.tid & 7; *(v4u*)(GATED + (size_t)(g0 + row) * D + h * 128 + 16 * c16) = *(const LAS v4u*)(os + row * OSP + 16 * c16); } };
    mload(0, wA, vA, gA); mload(1, wB, vB, gB);
    __syncthreads();
#pragma unroll 1
    for (int h = 0; h < 8; h += 2) {
        head(h, wA, vA, gA); mload(h + 2 < 8 ? h + 2 : 7, wA, vA, gA); __builtin_amdgcn_sched_barrier(0);
        head(h + 1, wB, vB, gB); mload(h + 3 < 8 ? h + 3 : 7, wB, vB, gB); __builtin_amdgcn_sched_barrier(0); }
    __syncthreads();
}

__device__ __forceinline__ void moe_tables(Frame& F) {
    LAS int* cnt = (LAS int*)(F.lds + TBL_CNT); LAS int* rs = (LAS int*)(F.lds + TBL_RS); LAS int* tpu = (LAS int*)(F.lds + TBL_TPU); LAS int* tpd = (LAS int*)(F.lds + TBL_TPD);
    if (F.tid == 0) { int r = 0, a = 0, b = 0;
        for (int e = 0; e < NE; ++e) { const int c = (int)__hip_atomic_load(F.ctl + CW_ECNT + e, RLX_AGENT); const int tiles = (c + 255) >> 8; cnt[e] = c; rs[e] = r; tpu[e] = a; tpd[e] = b; r += c; a += tiles * 8; b += tiles * 4; }
        rs[NE] = r; tpu[NE] = a; tpd[NE] = b; }
    __syncthreads();
}

struct RowIn { f32x4 x[4]; unsigned y[4]; };
__device__ __forceinline__ void row_load(RowIn& R, const float* x, const unsigned char* YO, int r, int lane) {
    const f32x4* xr = (const f32x4*)(x + (size_t)r * D) + lane; const unsigned* yr = (const unsigned*)(YO + (size_t)r * D) + lane;
#pragma unroll
    for (int j = 0; j < 4; ++j) { R.x[j] = xr[64 * j]; R.y[j] = yr[64 * j]; }
}
__device__ __forceinline__ void ln_inplace(f32x4 (&v)[4]) {
    float s = 0.f;
#pragma unroll
    for (int j = 0; j < 4; ++j) s += (v[j].x + v[j].y) + (v[j].z + v[j].w);
    const float mean = wave_sum(s) * (1.f / D); float s2 = 0.f;
#pragma unroll
    for (int j = 0; j < 4; ++j) { v[j] = v[j] - mean; s2 += (v[j].x * v[j].x + v[j].y * v[j].y) + (v[j].z * v[j].z + v[j].w * v[j].w); }
    const float rstd = __builtin_amdgcn_rsqf(wave_sum(s2) * (1.f / D) + LN_EPS);
#pragma unroll
    for (int j = 0; j < 4; ++j) v[j] = v[j] * rstd;
}
__device__ __forceinline__ void row_x1(const RowIn& R, f32x4 (&v)[4], const LAS float* g1, const LAS float* b1, int lane) {
#pragma unroll
    for (int j = 0; j < 4; ++j) { const f32x2 lo = __builtin_amdgcn_cvt_pk_f32_fp8((int)R.y[j], false), hi = __builtin_amdgcn_cvt_pk_f32_fp8((int)R.y[j], true); v[j] = R.x[j] * DN_ALPHA + (f32x4){lo.x, lo.y, hi.x, hi.y} * (1.0f / pg8::YO8_SCALE); }
    ln_inplace(v);
#pragma unroll
    for (int j = 0; j < 4; ++j) v[j] = v[j] * *(const LAS f32x4*)(g1 + 4 * lane + 256 * j) + *(const LAS f32x4*)(b1 + 4 * lane + 256 * j);
}

__device__ __forceinline__ void p6_router(Frame& F, const int xlocal, const int cx, unsigned* rdy) {
    LAS int* lcnt = (LAS int*)(F.lds + RT_CNT); LAS int* lbase = (LAS int*)(F.lds + RT_BASE); LAS int* rece = (LAS int*)(F.lds + RT_RECE); LAS int* recl = (LAS int*)(F.lds + RT_RECL); LAS float* recw = (LAS float*)(F.lds + RT_RECW);
    const float* mod = (const float*)(F.ws + WS_MOD); unsigned char* H2 = (unsigned char*)(F.ws + WS_H2);
    const unsigned char* YO = (const unsigned char*)(F.ws + WS_YO); const float* xin = INP(I_X); bf16* X1 = (bf16*)(F.ws + WS_X1);
    LAS float* pv = (LAS float*)(F.lds + PV6_OFF); const LAS float* g1 = pv; const LAS float* b1 = pv + D;
    v4u* tok = (v4u*)(F.ws + WS_TOK); int* list = (int*)(F.ws + WS_LIST);
    constexpr int HP = 2080, HLO = 16 * HP, PART = 2 * HLO;
    LAS unsigned char* hst = F.lds + RING_OFF; LAS float* part = (LAS float*)(F.lds + RING_OFF + PART);
    const int fr = F.lane & 15, fq = F.lane >> 4;
    bf16x8 whi[2][4], wlo[2][4];
    { const float* wsrc = (const float*)(F.ws + WS_WRT);
#pragma unroll
      for (int et = 0; et < 2; ++et)
#pragma unroll
          for (int ks = 0; ks < 4; ++ks) { const f32x4* pw = (const f32x4*)(wsrc + (size_t)(16 * et + fr) * D + F.wave * 128 + 32 * ks + 8 * fq); const f32x4 x0 = pw[0], x1 = pw[1];
              const v2u s0 = split_bf16(x0.x, x0.y), s1 = split_bf16(x0.z, x0.w), s2 = split_bf16(x1.x, x1.y), s3 = split_bf16(x1.z, x1.w); whi[et][ks] = (bf16x8)(v4u){s0.x, s1.x, s2.x, s3.x}; wlo[et][ks] = (bf16x8)(v4u){s0.y, s1.y, s2.y, s3.y}; } }
    const float brl = INP(I_BR)[F.lane & 31];
    const int rbstep = xlocal ? (T / 128) : F.G;
    for (int rb = xlocal ? (cx & 7) * (T / 128 / 8) + (cx >> 3) : (int)blockIdx.x; rb < T / 128; rb += rbstep) {
        if (xlocal) { if (F.tid == 0) { unsigned sp = 0u; while (__hip_atomic_load(rdy + (rb >> 1), RLX_AGENT) < 4u && ++sp < (1u << 22)) __builtin_amdgcn_s_sleep(2); }
            __syncthreads(); __builtin_amdgcn_fence(__ATOMIC_ACQUIRE, "agent"); asm volatile("s_waitcnt vmcnt(0)" ::: "memory"); }
        const int b = (rb * 128) >> 12, rw0 = rb * 128 + F.wave * 16;
        if (F.tid < NE) lcnt[F.tid] = 0;
        for (int i = F.tid; i < D; i += NWAVES * 64) { pv[i] = INP(I_P1G)[i]; pv[D + i] = INP(I_P1B)[i]; pv[2 * D + i] = mod[b * NMOD + MOD_SCALE2 + i] + 1.0f; pv[3 * D + i] = mod[b * NMOD + MOD_SHIFT2 + i]; }
        __syncthreads();
        RowIn RA, RB; row_load(RA, xin, YO, rw0, F.lane); row_load(RB, xin, YO, rw0 + 1, F.lane);
#pragma unroll 1
        for (int pr = 0; pr < 8; ++pr) {
            const int rl0 = F.wave * 16 + 2 * pr;
            f32x4 h[2][4];
#pragma unroll
            for (int q = 0; q < 2; ++q) {
                const int r = rb * 128 + rl0 + q;
                row_x1(q ? RB : RA, h[q], g1, b1, F.lane);
                { v2u* x1p = (v2u*)(X1 + (size_t)r * D) + F.lane;
#pragma unroll
                  for (int j = 0; j < 4; ++j) x1p[64 * j] = (v2u){pk2r(h[q][j].x, h[q][j].y), pk2r(h[q][j].z, h[q][j].w)}; }
                ln_inplace(h[q]);
                unsigned* o4 = (unsigned*)(H2 + (size_t)r * D) + F.lane;
#pragma unroll
                for (int j = 0; j < 4; ++j) { const f32x4 sc = *(const LAS f32x4*)(pv + 2 * D + 4 * F.lane + 256 * j), sh = *(const LAS f32x4*)(pv + 3 * D + 4 * F.lane + 256 * j);
                    h[q][j] = h[q][j] * sc + sh; o4[64 * j] = pg8::pk4_fp8(h[q][j].x, h[q][j].y, h[q][j].z, h[q][j].w); }
            }
            { const int rn = rw0 + (pr < 7 ? 2 * pr + 2 : 2 * pr); row_load(RA, xin, YO, rn, F.lane); row_load(RB, xin, YO, rn + 1, F.lane); }
#pragma unroll
            for (int q = 0; q < 2; ++q)
#pragma unroll
                for (int j = 0; j < 4; ++j) { const v2u s0 = split_bf16(h[q][j].x, h[q][j].y), s1 = split_bf16(h[q][j].z, h[q][j].w);
                    LAS unsigned char* d = hst + (2 * F.wave + q) * HP + (4 * F.lane + 256 * j) * 2; *(LAS v2u*)d = (v2u){s0.x, s1.x}; *(LAS v2u*)(d + HLO) = (v2u){s0.y, s1.y}; }
            LDS_WAIT(); __syncthreads();
            f32x4 lacc[2] = {{0.f, 0.f, 0.f, 0.f}, {0.f, 0.f, 0.f, 0.f}};
#pragma unroll
            for (int ks = 0; ks < 4; ++ks) { const LAS unsigned char* ap = hst + fr * HP + (F.wave * 128 + 32 * ks + 8 * fq) * 2; const bf16x8 ahi = *(const LAS bf16x8*)ap, alo = *(const LAS bf16x8*)(ap + HLO);
#pragma unroll
                for (int et = 0; et < 2; ++et) { lacc[et] = __builtin_amdgcn_mfma_f32_16x16x32_bf16(ahi, whi[et][ks], lacc[et], 0, 0, 0); lacc[et] = __builtin_amdgcn_mfma_f32_16x16x32_bf16(ahi, wlo[et][ks], lacc[et], 0, 0, 0); lacc[et] = __builtin_amdgcn_mfma_f32_16x16x32_bf16(alo, whi[et][ks], lacc[et], 0, 0, 0); } }
#pragma unroll
            for (int et = 0; et < 2; ++et)
#pragma unroll
                for (int r4 = 0; r4 < 4; ++r4) part[(F.wave * 16 + 4 * fq + r4) * 33 + 16 * et + fr] = lacc[et][r4];
            LDS_WAIT(); __syncthreads();
            float lsum = 0.f;
            { const int e_ = F.lane & 31, q_ = F.lane >> 5;
#pragma unroll
              for (int w_ = 0; w_ < NWAVES; ++w_) lsum += part[(w_ * 16 + 2 * F.wave + q_) * 33 + e_]; }
            const int e = F.lane & 31, q = F.lane >> 5; const float logit = lsum + brl;
            float tv[4]; int ti[4]; bool sel = false; int myk = 0;
#pragma unroll
            for (int k = 0; k < 4; ++k) { float cv = sel ? -3.0e38f : logit; int ci = e;
#define TK_STEP(ctrl) { const float ov = DPP_F(cv, ctrl); const int oi = DPP_I(ci, ctrl); if (ov > cv || (ov == cv && oi < ci)) { cv = ov; ci = oi; } }
                TK_STEP(DPP_XOR1) TK_STEP(DPP_XOR2) TK_STEP(DPP_HMIRROR) TK_STEP(DPP_MIRROR)
#undef TK_STEP
                { const int icv = __builtin_bit_cast(int, cv);
                  const float a0 = __builtin_bit_cast(float, __builtin_amdgcn_readlane(icv, 0)), a1 = __builtin_bit_cast(float, __builtin_amdgcn_readlane(icv, 16)), a2 = __builtin_bit_cast(float, __builtin_amdgcn_readlane(icv, 32)), a3 = __builtin_bit_cast(float, __builtin_amdgcn_readlane(icv, 48));
                  const int i0 = __builtin_amdgcn_readlane(ci, 0), i1 = __builtin_amdgcn_readlane(ci, 16), i2 = __builtin_amdgcn_readlane(ci, 32), i3 = __builtin_amdgcn_readlane(ci, 48);
                  const bool f01 = (a0 > a1 || (a0 == a1 && i0 < i1)), f23 = (a2 > a3 || (a2 == a3 && i2 < i3));
                  const float m01 = f01 ? a0 : a1, m23 = f23 ? a2 : a3; const int j01 = f01 ? i0 : i1, j23 = f23 ? i2 : i3;
                  cv = q ? m23 : m01; ci = q ? j23 : j01; }
                tv[k] = cv; ti[k] = ci; if (ci == e) { sel = true; myk = k; } }
            const float p1 = __expf(tv[1] - tv[0]), p2 = __expf(tv[2] - tv[0]), p3 = __expf(tv[3] - tv[0]), inv = 1.0f / (1.0f + p1 + p2 + p3);
            if (sel) { const float wk = (myk == 0 ? 1.0f : (myk == 1 ? p1 : (myk == 2 ? p2 : p3))) * inv; const int r = rb * 128 + rl0 + q;
                const int lr = __hip_atomic_fetch_add(lcnt + e, 1, __ATOMIC_RELAXED, __HIP_MEMORY_SCOPE_WORKGROUP);
                rece[(rl0 + q) * 4 + myk] = e; recl[(rl0 + q) * 4 + myk] = lr; recw[(rl0 + q) * 4 + myk] = wk; }
        }
        __syncthreads();
        if (F.tid < NE) lbase[F.tid] = (int)__hip_atomic_fetch_add(F.ctl + CW_ECNT + F.tid, (unsigned)lcnt[F.tid], RLX_AGENT);
        __syncthreads();
        { const int i = F.tid; const int e = rece[i], rank = lbase[e] + recl[i], r = rb * 128 + (i >> 2); tok[r * 4 + (i & 3)] = (v4u){(unsigned)e, (unsigned)rank, __float_as_uint(recw[i]), 0u}; list[(size_t)e * T + rank] = r; }
        __syncthreads();
    }
}

__device__ __forceinline__ void p10_combine(Frame& F) {
    const LAS int* rs = (const LAS int*)(F.lds + TBL_RS);
    const int gw = F.vcu * NWAVES + F.wave, NGW = F.G * NWAVES, RPW = (T + NGW - 1) / NGW;
    const int r0 = gw * RPW, r1 = (r0 + RPW) < T ? (r0 + RPW) : T;
    const float* mod = (const float*)(F.ws + WS_MOD); const unsigned char* Y = (const unsigned char*)(F.ws + WS_Y);
    const bf16* X1 = (const bf16*)(F.ws + WS_X1);
    LAS float* pv = (LAS float*)(F.lds + RING_OFF); const LAS float* g1 = pv; const LAS float* b1 = pv + D;
    { const int bb = (F.vcu * NWAVES * RPW) >> 12;
      for (int i = F.tid; i < D; i += NWAVES * 64) { pv[i] = INP(I_P1G)[i]; pv[D + i] = INP(I_P1B)[i]; pv[2 * D + i] = INP(I_P2G)[i]; pv[3 * D + i] = INP(I_P2B)[i]; pv[4 * D + i] = mod[bb * NMOD + MOD_GATE2 + i]; }
      __syncthreads(); }
    const v4u* tok = (const v4u*)(F.ws + WS_TOK);
    if (r0 >= r1) return;
    v2u XA[4], XB[4]; int ev[2], rv[2]; float wv[2];
#define P10_LOAD(r) do { const int ra_ = (r), rb_ = (ra_ + 1 < r1) ? ra_ + 1 : ra_; { const v2u* pa_ = (const v2u*)(X1 + (size_t)ra_ * D) + F.lane; const v2u* pb_ = (const v2u*)(X1 + (size_t)rb_ * D) + F.lane; _Pragma("unroll") for (int j_ = 0; j_ < 4; ++j_) { XA[j_] = pa_[64 * j_]; XB[j_] = pb_[64 * j_]; } } \
        const v4u t0_ = tok[ra_ * 4 + (F.lane & 3)], t1_ = tok[rb_ * 4 + (F.lane & 3)]; ev[0] = (int)t0_[0]; rv[0] = (int)t0_[1]; wv[0] = __uint_as_float(t0_[2]); ev[1] = (int)t1_[0]; rv[1] = (int)t1_[1]; wv[1] = __uint_as_float(t1_[2]); } while (0)
    P10_LOAD(r0);
#pragma unroll 1
    for (int r = r0; r < r1; r += 2) {
        const bool two = (r + 1 < r1);
        unsigned yv[2][4][4]; float wk[2][4];
#pragma unroll
        for (int q = 0; q < 2; ++q) { const int yrow_l = rs[ev[q]] + rv[q];
#pragma unroll
            for (int k = 0; k < 4; ++k) { const int yr = __builtin_amdgcn_readlane(yrow_l, k); wk[q][k] = __uint_as_float(__builtin_amdgcn_readlane(__float_as_uint(wv[q]), k)) * (1.0f / pg8::Y8_SCALE);     const unsigned* yp = (const unsigned*)(Y + (size_t)yr * D) + F.lane;
#pragma unroll
                for (int j = 0; j < 4; ++j) yv[q][k][j] = yp[64 * j]; } }
        f32x4 v[2][4];
#pragma unroll
        for (int j = 0; j < 4; ++j) { v[0][j] = (f32x4){bflo(XA[j].x), bfhi(XA[j].x), bflo(XA[j].y), bfhi(XA[j].y)}; v[1][j] = (f32x4){bflo(XB[j].x), bfhi(XB[j].x), bflo(XB[j].y), bfhi(XB[j].y)}; }
        if (r + 2 < r1) P10_LOAD(r + 2);
#pragma unroll
        for (int q = 0; q < 2; ++q) {
#pragma unroll
            for (int j = 0; j < 4; ++j) { f32x2 yl = {0.f, 0.f}, yh = {0.f, 0.f};
#pragma unroll
                for (int k = 0; k < 4; ++k) { const unsigned w = yv[q][k][j]; const f32x2 lo = __builtin_amdgcn_cvt_pk_f32_fp8((int)w, false), hi = __builtin_amdgcn_cvt_pk_f32_fp8((int)w, true); const f32x2 wk2 = {wk[q][k], wk[q][k]};
                    yl = __builtin_elementwise_fma(wk2, lo, yl); yh = __builtin_elementwise_fma(wk2, hi, yh); }
                v[q][j] = v[q][j] * DN_ALPHA + *(const LAS f32x4*)(pv + 4 * D + 4 * F.lane + 256 * j) * (f32x4){yl.x, yl.y, yh.x, yh.y}; }
            ln_inplace(v[q]);
            if (q == 0 || two) { f32x4* orow = (f32x4*)(F.out + (size_t)(r + q) * D) + F.lane;
#pragma unroll
                for (int j = 0; j < 4; ++j) orow[64 * j] = v[q][j] * *(const LAS f32x4*)(pv + 2 * D + 4 * F.lane + 256 * j) + *(const LAS f32x4*)(pv + 3 * D + 4 * F.lane + 256 * j); }
        }
    }
#undef P10_LOAD
}

struct Args { const float* in[30]; float* out; unsigned char* ws; int ph_lo, ph_hi; };
__global__ void __launch_bounds__(NWAVES * 64, 2) mk_fwd(Args args) {
    extern __shared__ __attribute__((aligned(16))) unsigned char lds[];
    Frame F;
    F.lds = (LAS unsigned char*)lds;
    F.MISC = (volatile LAS unsigned*)(F.lds + MISC_OFF);
    F.tid = threadIdx.x; F.lane = F.tid & 63; F.wave = __builtin_amdgcn_readfirstlane(F.tid >> 6);
    F.G = gridDim.x; { const int bx = blockIdx.x; F.vcu = (F.G % 8 == 0) ? (bx % 8) * (F.G / 8) + bx / 8 : bx; }
    F.ws = args.ws; F.ctl = (gu32*)(args.ws + WS_CTL); F.out = args.out;
    F.karg = (const __attribute__((address_space(4))) char*)__builtin_amdgcn_kernarg_segment_ptr();
    for (int u = F.tid; u < (LDS_BYTES - LDSCTL_OFF) / 4; u += NWAVES * 64) ((LAS unsigned*)(F.lds + LDSCTL_OFF))[u] = 0u;
    __syncthreads();
    XcdBarrier bar; bar.bar = (unsigned*)(F.ctl + CW_BAR); bar.x = 0; bar.st = nullptr;
    if (N_LAUNCHES == 1) bar = xcd_barrier_post((unsigned*)(F.ctl + CW_BAR), F.MISC + 8);
    if (N_LAUNCHES == 1 && F.tid == 0) F.MISC[19] = __hip_atomic_fetch_add(F.ctl + CW_XRANK + 64 * bar.x, 1u, RLX_AGENT);
#define GRID_BAR() do { if (N_LAUNCHES == 1) xcd_barrier(bar); } while (0)
    const int lo = args.ph_lo, hi = args.ph_hi;
#ifndef PHASE_MASK
#define PHASE_MASK 0x3ff
#endif
#define IN(k) ((((PHASE_MASK) >> (k)) & 1) && lo <= (k) && (k) < hi)
#define BOTH(k) (IN(k) && IN((k) + 1))
    using namespace pg8;
    PG8_LAS unsigned char* ring = F.lds + RING_OFF;
    bf16* const W_IN = (bf16*)(F.ws + WS_WIN); bf16* const W_PA = (bf16*)(F.ws + WS_WPA); bf16* const W_PB = (bf16*)(F.ws + WS_WPB); bf16* const W_OUT = (bf16*)(F.ws + WS_WOUT);
    bf16* const W_UP = (bf16*)(F.ws + WS_WUP); bf16* const W_DN = (bf16*)(F.ws + WS_WDN);

#ifdef NO_CONV
#define P3_CONV(F, u)
#else
#define P3_CONV(F, u) p3_conv_unit(F, u)
#endif
#ifdef NO_MIX
#define P3_MIX(F, u)
#else
#define P3_MIX(F, u) p3_mix_unit(F, u)
#endif
#ifndef REPEAT_MASK
#define REPEAT_MASK 0
#endif
#define NREP(k) (1 + (((REPEAT_MASK) >> (k)) & 1))
#define PHASE(k, ...) if (IN(k)) { { int l_ = (int)__builtin_amdgcn_mbcnt_hi(~0u, __builtin_amdgcn_mbcnt_lo(~0u, 0u)); asm volatile("" : "+v"(l_)); F.lane = l_; F.tid = F.wave * 64 + l_; }     \
    for (int rep_ = 0; rep_ < NREP(k); ++rep_) { __VA_ARGS__ if (rep_ + 1 < NREP(k)) GRID_BAR(); } if (BOTH(k) && (k) != 7 && !(xlocal && ((k) == 1 || (k) == 2 || (k) == 3 || (k) == 4 || (k) == 5))) GRID_BAR(); }
    int xlocal = 0, cx = (int)blockIdx.x;
    PHASE(0, p0_prologue(F);)
    { if (F.tid == 0) { unsigned dx, nxc, nloc, k, ok;
          if (N_LAUNCHES == 1) { dx = 0u; nxc = 0u; ok = 1u;
#pragma unroll
              for (unsigned j = 0; j < 16; ++j) { const unsigned c_ = xb_ld(bar.bar + XB_XCNT(j)); if (c_) { if (j < bar.x) ++dx; ++nxc; if (c_ * 8u != (unsigned)F.G) ok = 0u; } }
              nloc = F.MISC[8]; k = F.MISC[19]; if (nloc == 0u) nloc = 1u; if (k >= nloc) { k = nloc - 1u; ok = 0u; } if (nxc != 8u) ok = 0u; }
          else { dx = blockIdx.x & 7u; nxc = 8u; k = blockIdx.x >> 3; nloc = (unsigned)(F.G - (int)dx + 7) >> 3; ok = 0u; }
          F.MISC[16] = dx; F.MISC[17] = nxc; F.MISC[18] = nloc; F.MISC[20] = k; F.MISC[21] = ok; F.MISC[22] = ok ? (8u * k + dx) : blockIdx.x; }
      __syncthreads(); }
    xlocal = __builtin_amdgcn_readfirstlane((int)F.MISC[21]); cx = __builtin_amdgcn_readfirstlane((int)F.MISC[22]);
    unsigned* const rdy45 = (unsigned*)(F.ctl + CW_READY + 1024); unsigned* const rdy56 = (unsigned*)(F.ctl + CW_READY + 1280); unsigned* const rdy12 = (unsigned*)(F.ctl + CW_READY + 1536); unsigned* const rdy34 = (unsigned*)(F.ctl + CW_READY + 1792); unsigned* const rdy23 = (unsigned*)(F.ctl + CW_READY + 2048);
    const int moe_slot = xlocal ? ((0x04100410 >> (4 * (cx & 7))) & 15) : 0;
    const int moe_ty = xlocal ? (moe_slot == 0 ? 0 : (moe_slot == 1 ? 1 : 2)) : -1;
    const int moe_tr = xlocal ? (((0x31121000 >> (4 * (cx & 7))) & 15) * (F.G >> 3) + (cx >> 3)) * NWAVES + F.wave : 0;
    PHASE(1, if (moe_slot == 0) p0_moe_weights(F, moe_ty, moe_tr); p1_lnmod(F, xlocal, cx, rdy12);)
    PHASE(2,
        DenseOrder S; S.init(F.ws + WS_H, W_IN, T, IN_DIM, D, F.G, cx); if (xlocal) { S.ready_in = rdy12; S.need = 2u; S.ready_out = rdy23; }
        EpiG1 E{(bf16*)(F.ws + WS_Z), (bf16*)(F.ws + WS_GU), (size_t)(UB / 2), (const float*)(F.ws + WS_BINP), F.lds + EVEC_OFF};
        gemm_phase<EpiG1, DenseOrder, PG8_ALIGN, true>(ring, D, S, E, F.tid);)
    PHASE(3,
        if (moe_slot == 1) p0_moe_weights(F, moe_ty, moe_tr);
        for (int u = xlocal ? (cx & 7) * (T / 128 / 8) + (cx >> 3) : (int)blockIdx.x; u < T / 128; u += (xlocal ? T / 128 : F.G)) {
            if (xlocal) { if (F.tid == 0) { unsigned sp = 0u; const int mt_ = u >> 1, mh_ = ((u & 1) == 0 && (u & 31) != 0) ? mt_ - 1 : mt_;
                    while ((__hip_atomic_load(rdy23 + mt_, RLX_AGENT) < (unsigned)(IN_DIM / 256) || __hip_atomic_load(rdy23 + mh_, RLX_AGENT) < (unsigned)(IN_DIM / 256)) && ++sp < (1u << 22)) __builtin_amdgcn_s_sleep(2); }
                __syncthreads(); }
            P3_CONV(F, u); { int l_ = (int)__builtin_amdgcn_mbcnt_hi(~0u, __builtin_amdgcn_mbcnt_lo(~0u, 0u)); asm volatile("" : "+v"(l_)); F.lane = l_; F.tid = F.wave * 64 + l_; } P3_MIX(F, u);
            if (xlocal) { asm volatile("s_waitcnt vmcnt(0)" ::: "memory"); __syncthreads(); if (F.tid == 0) (void)__hip_atomic_fetch_add(rdy34 + (u >> 1), 1u, RLX_AGENT); } })
    PHASE(4,
        { DenseOrder S; S.init(F.ws + WS_AACT, W_PA, T, D, D, F.G, cx); if (xlocal) { S.ready_in = rdy34; S.need = 2u; }
          EpiGate<0> E{(bf16*)(F.ws + WS_M1), (unsigned char*)(F.ws + WS_MERGED), (const unsigned char*)(F.ws + WS_SGA), INP(I_BPA), F.lds + EVEC_OFF};
          gemm_phase<EpiGate<0>, DenseOrder, PG8_ALIGN, true>(ring, D, S, E, F.tid); }
        { DenseOrder S; S.init(F.ws + WS_GATED, W_PB, T, D, D, F.G, cx); if (xlocal) { S.ready_out = rdy45; S.ready_in = rdy34; S.need = 2u; }
          EpiGate<1> E{(bf16*)(F.ws + WS_M1), (unsigned char*)(F.ws + WS_MERGED), (const unsigned char*)(F.ws + WS_SGB), INP(I_BPB), F.lds + EVEC_OFF};
          gemm_phase<EpiGate<1>, DenseOrder, PG8_ALIGN, true>(ring, D, S, E, F.tid); })
    PHASE(5,
        DenseOrder S; S.init(F.ws + WS_MERGED, W_OUT, T, D, D, F.G, cx); if (xlocal) { S.ready_in = rdy45; S.need = 4u; S.ready_out = rdy56; }
        EpiYO E{(unsigned char*)(F.ws + WS_YO), INP(I_BOUT), (const float*)(F.ws + WS_MOD) + MOD_GATE1, F.lds + EVEC_OFF};
        gemm_phase<EpiYO, DenseOrder, PG8_ALIGN, true>(ring, D, S, E, F.tid);)
    PHASE(6, p6_router(F, xlocal, cx, rdy56); if (moe_slot == 4) p0_moe_weights(F, moe_ty, moe_tr);)
    auto moe_split = [&](const PG8_LAS int* tp, const int npn, const bool down, int& base, int& stride, int& nun) {
        const int dx = (int)F.MISC[16], nxc = (int)F.MISC[17], nloc = (int)F.MISC[18], k = (int)F.MISC[20];
        const int totm = __builtin_amdgcn_readfirstlane(tp[32]) / npn, cm = (totm + nxc - 1) / nxc;
        const int m0 = dx * cm, m1 = (m0 + cm) < totm ? (m0 + cm) : totm, lenm = m1 > m0 ? m1 - m0 : 0;
        int kk = k; if (down) { const int r7 = (lenm * 8) % nloc; kk = (k + nloc - r7) % nloc; }
        const int len = lenm * npn; base = m0 * npn + kk; stride = nloc; nun = len > kk ? (len - kk + nloc - 1) / nloc : 0;
        __syncthreads(); };
    PHASE(7,
        moe_tables(F);
        int sb_, ss_, sn_; moe_split((const PG8_LAS int*)(F.lds + TBL_TPU), 8, false, sb_, ss_, sn_);
        GroupedOrder<true> S{(const PG8_LAS int*)(F.lds + TBL_TPU), (const PG8_LAS int*)(F.lds + TBL_RS), (const PG8_LAS int*)(F.lds + TBL_CNT), 8, sb_, ss_, sn_, (unsigned*)(F.ctl + CW_READY),
                       (const char*)(F.ws + WS_H2), (const char*)W_UP, (size_t)D, (size_t)BM * D, (size_t)2048 * D, (const int*)(F.ws + WS_LIST), (PG8_LAS unsigned*)(F.lds + GTAB_OFF)};
        EpiSwiglu E{(unsigned char*)(F.ws + WS_ACT), (const float*)(F.ws + WS_BUPP), F.lds + EVEC_OFF};
        gemm_phase<EpiSwiglu, GroupedOrder<true>, PG8_ALIGN, true>(ring, D, S, E, F.tid);)
    PHASE(8,
        if (!IN(7)) moe_tables(F);
        int sb_, ss_, sn_; moe_split((const PG8_LAS int*)(F.lds + TBL_TPD), 4, true, sb_, ss_, sn_);
        GroupedOrder<false> S{(const PG8_LAS int*)(F.lds + TBL_TPD), (const PG8_LAS int*)(F.lds + TBL_RS), (const PG8_LAS int*)(F.lds + TBL_CNT), 4, sb_, ss_, sn_, (unsigned*)(F.ctl + CW_READY),
                       (const char*)(F.ws + WS_ACT), (const char*)W_DN, (size_t)D, (size_t)BM * D, (size_t)D * D, nullptr, nullptr};
        EpiDown E{(unsigned char*)(F.ws + WS_Y), INP(I_BDN), F.lds + STG_OFF, F.lds + EVEC_OFF};
        gemm_phase<EpiDown, GroupedOrder<false>, PG8_ALIGN, true>(ring, D, S, E, F.tid);)
    PHASE(9,
        if (!IN(7)) moe_tables(F);
        p10_combine(F);)
#undef PHASE
#undef NREP
#undef IN
#undef BOTH
#undef GRID_BAR
}

extern "C" void kernel_launch(void* const* d_in, const int* in_sizes, int n_in, void* d_out, int out_size, void* d_ws, size_t ws_size, hipStream_t stream) {
    static int grid = 0;
    if (grid == 0) {
        if (n_in != 30 || in_sizes[0] != T * D || out_size != T * D || ws_size < WS_END) { fprintf(stderr, "kernel_launch: unexpected shapes (n_in %d, in0 %d, out %d, ws %zu); nothing launched\n", n_in, n_in > 0 ? in_sizes[0] : -1, out_size, ws_size); grid = -1; return; }
        int dev = 0, cus = 0, per_cu = 0;
        if (hipGetDevice(&dev) != hipSuccess || hipDeviceGetAttribute(&cus, hipDeviceAttributeMultiprocessorCount, dev) != hipSuccess) { fprintf(stderr, "kernel_launch: device query failed\n"); grid = -1; return; }
        if (hipFuncSetAttribute((const void*)mk_fwd, hipFuncAttributeMaxDynamicSharedMemorySize, LDS_BYTES) != hipSuccess) { fprintf(stderr, "kernel_launch: hipFuncSetAttribute failed\n"); grid = -1; return; }
        if (hipOccupancyMaxActiveBlocksPerMultiprocessor(&per_cu, (const void*)mk_fwd, NWAVES * 64, LDS_BYTES) != hipSuccess || per_cu < 1) { fprintf(stderr, "kernel_launch: occupancy query reports %d workgroups per CU\n", per_cu); per_cu = 1; }
        (void)hipGetLastError();
        grid = cus;
    }
    if (grid < 0) return;
    if (hipMemsetAsync((char*)d_ws + WS_CTL, 0, CTL_ZERO_BYTES, stream) != hipSuccess) { fprintf(stderr, "kernel_launch: hipMemsetAsync failed\n"); return; }
    Args a{};
    for (int i = 0; i < 30; ++i) a.in[i] = (const float*)d_in[i];
    a.out = (float*)d_out; a.ws = (unsigned char*)d_ws;
    if (N_LAUNCHES == 1) {
        a.ph_lo = 0; a.ph_hi = NPH;
        void* kargs[] = {&a};
        hipError_t le = hipLaunchCooperativeKernel((const void*)mk_fwd, dim3(grid), dim3(NWAVES * 64), kargs, LDS_BYTES, stream);
        if (le != hipSuccess) { (void)hipGetLastError(); fprintf(stderr, "kernel_launch: cooperative launch failed (%s), plain launch instead\n", hipGetErrorName(le)); hipLaunchKernelGGL(mk_fwd, dim3(grid), dim3(NWAVES * 64), LDS_BYTES, stream, a); }
    } else {
        for (int li = 0; li < NPH; ++li) for (int rp = 0; rp < 1 + ((HOST_REPEAT >> li) & 1); ++rp) { a.ph_lo = li; a.ph_hi = li + 1; hipLaunchKernelGGL(mk_fwd, dim3(grid), dim3(NWAVES * 64), LDS_BYTES, stream, a); }
    }
}
```
